# Optimizing an MI355X kernel written in HIP

```python
import math
import jax, jax.numpy as jnp
from jax import lax
import numpy as np

D_MODEL = 1024
BATCH = 16
SEQ = 2048
DEPTH = 4

N_MIXERS = 2
N_A_LAYERS = (DEPTH + 1) // 2
N_B_LAYERS = DEPTH // 2

GLA_HEADS = 4
GLA_DK = (D_MODEL // 2) // GLA_HEADS
GLA_DV = D_MODEL // GLA_HEADS
GLA_GATE_RANK = 16
GLA_GATE_NORM = 16.0
GLA_CHUNK = 64
GLA_QK = GLA_HEADS * GLA_DK
GLA_V = GLA_HEADS * GLA_DV
GLA_IN = 2 * GLA_QK + 2 * GLA_V + 2 * GLA_GATE_RANK

DIFF_HEADS = 8
DIFF_DH = D_MODEL // DIFF_HEADS // 2
DIFF_QK = DIFF_HEADS * 2 * DIFF_DH
DIFF_V = DIFF_HEADS * 2 * DIFF_DH
DIFF_IN = 2 * DIFF_QK + DIFF_V
Q_BLOCK = 128

REL_BUCKETS = 32
REL_MAX_DIST = 128

D_FF = 2816
EPS = 1e-6

kernel_name = "hybrid_gla_diffattn_macaron_encoder"


def rms_norm(x, g):
    xf = x.astype(jnp.float32)
    y = xf * lax.rsqrt(jnp.mean(xf * xf, axis=-1, keepdims=True) + EPS)
    return (y * g.astype(jnp.float32)).astype(x.dtype)


def swiglu_ffn(h, w_gu, w_down):
    gate, up = jnp.split(h @ w_gu, 2, axis=-1)
    return (jax.nn.silu(gate) * up) @ w_down


def gla_chunked(q, k, v, log_a, strict):
    B, H, S, dk = q.shape
    dv = v.shape[-1]
    n = S // GLA_CHUNK

    def to_chunks(t):
        return jnp.moveaxis(t.reshape(B, H, n, GLA_CHUNK, t.shape[-1]), 2, 0)

    mask = jnp.tril(jnp.ones((GLA_CHUNK, GLA_CHUNK), dtype=bool), k=-1 if strict else 0)

    def step(state, inp):
        qc, kc, vc, gc = inp
        b = jnp.cumsum(gc, axis=-2)
        inter = jnp.einsum('bhcd,bhdv->bhcv', qc * jnp.exp(b), state)
        rel = jnp.minimum(b[:, :, :, None, :] - b[:, :, None, :, :], 0.0)
        decay = jnp.where(mask[:, :, None], jnp.exp(rel), 0.0)
        scores = jnp.sum(qc[:, :, :, None, :] * kc[:, :, None, :, :] * decay, axis=-1)
        intra = jnp.einsum('bhij,bhjv->bhiv', scores, vc)
        b_end = b[:, :, -1:, :]
        k_dec = kc * jnp.exp(b_end - b)
        new_state = jnp.exp(b_end[:, :, 0, :])[..., None] * state + jnp.einsum('bhcd,bhcv->bhdv', k_dec, vc)
        return new_state, inter + intra

    state0 = jnp.zeros((B, H, dk, dv), jnp.float32)
    _, out = lax.scan(step, state0, (to_chunks(q), to_chunks(k), to_chunks(v), to_chunks(log_a)))
    return jnp.moveaxis(out, 0, 2).reshape(B, H, S, dv)


def gla_mixer(h, w_in, w_gate2, b_gate, o_norm_g, w_out):
    B, S, _ = h.shape
    proj = h @ w_in
    q, k, v, g, lr = jnp.split(proj, [GLA_QK, 2 * GLA_QK, 2 * GLA_QK + GLA_V, 2 * GLA_QK + 2 * GLA_V], axis=-1)
    lr_f, lr_b = lr[..., :GLA_GATE_RANK], lr[..., GLA_GATE_RANK:]

    def heads(t, d):
        return t.reshape(B, S, GLA_HEADS, d).transpose(0, 2, 1, 3).astype(jnp.float32)

    def log_decay(lr_d, w2, bias):
        z = (lr_d @ w2 + bias).astype(jnp.float32)
        return jax.nn.log_sigmoid(z) / GLA_GATE_NORM

    qh = heads(q, GLA_DK) * (GLA_DK ** -0.5)
    kh = heads(k, GLA_DK)
    vh = heads(v, GLA_DV)
    la_f = heads(log_decay(lr_f, w_gate2[0], b_gate[0]), GLA_DK)
    la_b = heads(log_decay(lr_b, w_gate2[1], b_gate[1]), GLA_DK)

    flip = lambda t: jnp.flip(t, axis=2)
    o_f = gla_chunked(qh, kh, vh, la_f, False)
    o_b = flip(gla_chunked(flip(qh), flip(kh), flip(vh), flip(la_b), True))
    o = (o_f + o_b).transpose(0, 2, 1, 3)
    o = rms_norm(o, o_norm_g).reshape(B, S, GLA_V).astype(h.dtype) * jax.nn.silu(g)
    return o @ w_out


def t5_bucket(rel):
    nb = REL_BUCKETS // 2
    max_exact = nb // 2
    ret = (rel > 0).astype(jnp.int32) * nb
    n = jnp.abs(rel)
    nf = jnp.maximum(n, 1).astype(jnp.float32)
    large = max_exact + (jnp.log(nf / max_exact) / math.log(REL_MAX_DIST / max_exact) * (nb - max_exact)).astype(jnp.int32)
    large = jnp.minimum(large, nb - 1)
    return ret + jnp.where(n < max_exact, n, large)


def diff_mixer(h, w_in, qk_norm_g, lam_vecs, subln_g, w_out, rel_table, lam_init):
    B, S, _ = h.shape
    proj = h @ w_in
    q, k, v = jnp.split(proj, [DIFF_QK, 2 * DIFF_QK], axis=-1)
    q = rms_norm(q.reshape(B, S, DIFF_HEADS, 2, DIFF_DH), qk_norm_g[0]).astype(jnp.float32) * (DIFF_DH ** -0.5)
    k = rms_norm(k.reshape(B, S, DIFF_HEADS, 2, DIFF_DH), qk_norm_g[1]).astype(jnp.float32)
    q1 = q[..., 0, :].transpose(0, 2, 1, 3)
    q2 = q[..., 1, :].transpose(0, 2, 1, 3)
    k1 = k[..., 0, :].transpose(0, 2, 1, 3)
    k2 = k[..., 1, :].transpose(0, 2, 1, 3)
    vh = v.reshape(B, S, DIFF_HEADS, 2 * DIFF_DH).transpose(0, 2, 1, 3).astype(jnp.float32)

    lv = lam_vecs.astype(jnp.float32)
    lam = jnp.exp(jnp.sum(lv[0] * lv[1])) - jnp.exp(jnp.sum(lv[2] * lv[3])) + lam_init
    table = rel_table.astype(jnp.float32)
    nblk = S // Q_BLOCK
    kpos = jnp.arange(S, dtype=jnp.int32)

    def blocks(t):
        return jnp.moveaxis(t.reshape(B, DIFF_HEADS, nblk, Q_BLOCK, DIFF_DH), 2, 0)

    def attend(args):
        q1b, q2b, start = args
        qpos = start + jnp.arange(Q_BLOCK, dtype=jnp.int32)
        bias = jnp.transpose(table[t5_bucket(kpos[None, :] - qpos[:, None])], (2, 0, 1))
        p1 = jax.nn.softmax(jnp.einsum('bhqd,bhkd->bhqk', q1b, k1) + bias, axis=-1)
        p2 = jax.nn.softmax(jnp.einsum('bhqd,bhkd->bhqk', q2b, k2) + bias, axis=-1)
        return jnp.einsum('bhqk,bhkv->bhqv', p1 - lam * p2, vh)

    starts = jnp.arange(nblk, dtype=jnp.int32) * Q_BLOCK
    out = lax.map(attend, (blocks(q1), blocks(q2), starts))
    out = out.transpose(1, 0, 3, 2, 4).reshape(B, S, DIFF_HEADS, 2 * DIFF_DH)
    out = rms_norm(out, subln_g) * (1.0 - lam_init)
    return out.reshape(B, S, DIFF_V).astype(h.dtype) @ w_out


def setup_inputs(seed: int = 0) -> dict:
    key = jax.random.key(seed)
    ks = jax.random.split(key, 16)
    f32 = jnp.float32
    nrm = lambda k, shape, s: jax.random.normal(k, shape, f32) * s
    return {
        "x": nrm(ks[0], (BATCH, SEQ, D_MODEL), 1.0),
        "norm_g": 1.0 + nrm(ks[1], (DEPTH, 3, D_MODEL), 0.02),
        "ffn_w_gu": nrm(ks[2], (DEPTH, 2, D_MODEL, 2 * D_FF), D_MODEL ** -0.5),
        "ffn_w_down": nrm(ks[3], (DEPTH, 2, D_FF, D_MODEL), D_FF ** -0.5),
        "gla_w_in": nrm(ks[4], (N_A_LAYERS, D_MODEL, GLA_IN), D_MODEL ** -0.5),
        "gla_w_gate2": nrm(ks[5], (N_A_LAYERS, 2, GLA_GATE_RANK, GLA_QK), GLA_GATE_RANK ** -0.5),
        "gla_b_gate": nrm(ks[6], (N_A_LAYERS, 2, GLA_QK), 0.1),
        "gla_o_norm_g": 1.0 + nrm(ks[7], (N_A_LAYERS, GLA_DV), 0.02),
        "gla_w_out": nrm(ks[8], (N_A_LAYERS, GLA_V, D_MODEL), GLA_V ** -0.5),
        "diff_w_in": nrm(ks[9], (N_B_LAYERS, D_MODEL, DIFF_IN), D_MODEL ** -0.5),
        "diff_qk_norm_g": 1.0 + nrm(ks[10], (N_B_LAYERS, 2, DIFF_DH), 0.02),
        "diff_lambda": nrm(ks[11], (N_B_LAYERS, 4, DIFF_DH), 0.1),
        "diff_subln_g": 1.0 + nrm(ks[12], (N_B_LAYERS, 2 * DIFF_DH), 0.02),
        "diff_w_out": nrm(ks[13], (N_B_LAYERS, DIFF_V, D_MODEL), DIFF_V ** -0.5),
        "rel_bias_table": nrm(ks[14], (REL_BUCKETS, DIFF_HEADS), 0.5),
    }


def reference(x, norm_g, ffn_w_gu, ffn_w_down, gla_w_in, gla_w_gate2, gla_b_gate, gla_o_norm_g,
              gla_w_out, diff_w_in, diff_qk_norm_g, diff_lambda, diff_subln_g, diff_w_out, rel_bias_table):
    for i in range(DEPTH):
        j = i // N_MIXERS
        x = x + 0.5 * swiglu_ffn(rms_norm(x, norm_g[i, 0]), ffn_w_gu[i, 0], ffn_w_down[i, 0])
        h = rms_norm(x, norm_g[i, 1])
        if i % N_MIXERS == 0:
            x = x + gla_mixer(h, gla_w_in[j], gla_w_gate2[j], gla_b_gate[j], gla_o_norm_g[j], gla_w_out[j])
        else:
            lam_init = 0.8 - 0.6 * math.exp(-0.3 * i)
            x = x + diff_mixer(h, diff_w_in[j], diff_qk_norm_g[j], diff_lambda[j], diff_subln_g[j],
                               diff_w_out[j], rel_bias_table, lam_init)
        x = x + 0.5 * swiglu_ffn(rms_norm(x, norm_g[i, 2]), ffn_w_gu[i, 1], ffn_w_down[i, 1])
    return x
```

```cpp
#include <hip/hip_runtime.h>
#include <hip/hip_cooperative_groups.h>
#include <cstdio>
#include <cstdint>
namespace cg = cooperative_groups;
namespace pg8 {
#define PG8_LAS __attribute__((address_space(3)))
typedef unsigned short bf16_t;
typedef short bf16x8 __attribute__((ext_vector_type(8)));
typedef float f32x4 __attribute__((ext_vector_type(4)));
typedef unsigned u32x4 __attribute__((ext_vector_type(4)));
constexpr int BM = 256, BK = 64, HALF = 128, HTB = HALF * BK * 2  , STAGE_BYTES = 8 * HTB, NXCD = 8, WGM = 8;

__host__ __device__ __forceinline__ int lds_byte(int r, int c) { const int st = (r >> 4) * 2 + (c >> 5), rr = r & 15, cc = c & 31, ob = rr * 64 + cc * 2; return st * 1024 + (ob ^ (((ob >> 9) & 1) << 5)); }
__host__ __device__ __forceinline__ void stage_rc(int b, int& R, int& C) { const int st = b / 1024, sb = b % 1024, swz = sb ^ (((sb >> 9) & 1) << 5); R = (st >> 1) * 16 + swz / 64; C = (st & 1) * 32 + (swz % 64) / 2; }
__host__ __device__ __forceinline__ int perm32(int rho) { const int n = rho >> 4, i = rho & 15; return 8 * (i >> 2) + 4 * n + (i & 3); }

struct Unit { int pm, pn; };
struct Gemm { const bf16_t* A; const bf16_t* Bt; int M, N, K; };

struct StaticOrder {
    int nM, nN, nwg, G, c;
    __host__ __device__ void init(int M, int N, int G_, int c_) { nM = M / BM; nN = N / BM; nwg = nM * nN; G = G_; c = c_; }
    __host__ __device__ bool next(int i, Unit& u) const {
        const long L = (long)i * G + c; if (L >= nwg) return false;
        int wgid = (int)L; { const int q = nwg / NXCD, r = nwg % NXCD, xcd = wgid % NXCD, off = wgid / NXCD; wgid = (xcd < r ? xcd * (q + 1) : r * (q + 1) + (xcd - r) * q) + off; }
        const int nig = WGM * nN, gid = wgid / nig, fm = gid * WGM, gsz = (nM - fm) < WGM ? (nM - fm) : WGM;
        u.pm = fm + ((wgid % nig) % gsz); u.pn = (wgid % nig) / gsz; return true;
    }
    __device__ __forceinline__ void a_ready(const Unit&) const {}
    __device__ __forceinline__ void done(const Unit&) const {}
};
__device__ __forceinline__ unsigned cvt_pk_bf16(float lo, float hi) { unsigned r; asm volatile("v_cvt_pk_bf16_f32 %0, %1, %2" : "=v"(r) : "v"(lo), "v"(hi)); return r; }
template <class Epi, class Sched, bool ALIGN_EPI = false, bool SP2 = false>
__device__ __forceinline__ void gemm_phase(PG8_LAS unsigned char* lds, const Gemm g, const Sched& S, const Epi& E, const int wave_s) {
    unsigned z_ = 0u; asm volatile("" : "+v"(z_)); int tid_ = wave_s * 64 + (int)__builtin_amdgcn_mbcnt_hi(~0u, __builtin_amdgcn_mbcnt_lo(~0u, z_)); asm volatile("" : "+v"(tid_)); const int tid = tid_, wid = __builtin_amdgcn_readfirstlane(tid >> 6), lane = tid & 63, wr = wid >> 2, wc = wid & 3, fr = lane & 15, fq = lane >> 4;
    const int K = g.K, nt = K / BK;
    unsigned voffA[2], voffB[2];
#pragma unroll
    for (int i = 0; i < 2; ++i) { int R, C; stage_rc(tid * 16 + i * 8192, R, C); const int Rb = Epi::PERM ? ((R & ~31) + perm32(R & 31)) : R;
        voffA[i] = (unsigned)(R * K + C) * 2u; voffB[i] = (unsigned)(Rb * K + C) * 2u; }
    const size_t kstep = (size_t)(BK * 2);
    const size_t hstep = (size_t)HALF * K * 2;
    const size_t tstep = 2 * hstep;
    const unsigned ldsw = (unsigned)wid * 1024u;
    const int aoff = lds_byte(wr * 64 + fr, fq * 8), boff = lds_byte(wc * 32 + fr, fq * 8);
#define PG8_SA(b, h) (((b) * 2 + (h)) * HTB)
#define PG8_SB(b, h) ((4 + (b) * 2 + (h)) * HTB)
#define PG8_STAGE(bufoff, gbase, voff) do { _Pragma("unroll") for (int _i = 0; _i < 2; ++_i) \
        __builtin_amdgcn_global_load_lds((const unsigned*)((const char*)(gbase) + (voff)[_i]), (PG8_LAS unsigned*)(lds + (bufoff) + ldsw + _i * 8192), 16, 0, 0); } while (0)
#define PG8_LDA(dst, b, h) do { _Pragma("unroll") for (int m = 0; m < 4; ++m) _Pragma("unroll") for (int k = 0; k < 2; ++k) dst[m][k] = *(const PG8_LAS bf16x8*)(lds + PG8_SA(b, h) + aoff + m * 2048 + k * 1024); } while (0)
#define PG8_LDB(dst, b, h) do { _Pragma("unroll") for (int n = 0; n < 2; ++n) _Pragma("unroll") for (int k = 0; k < 2; ++k) dst[n][k] = *(const PG8_LAS bf16x8*)(lds + PG8_SB(b, h) + boff + n * 2048 + k * 1024); } while (0)
#define PG8_MMA(ai, bj, At, Bt) do { __builtin_amdgcn_s_setprio(1); _Pragma("unroll") for (int m = 0; m < 4; ++m) _Pragma("unroll") for (int n = 0; n < 2; ++n) _Pragma("unroll") for (int k = 0; k < 2; ++k) \
        acc[ai][bj][m][n] = __builtin_amdgcn_mfma_f32_16x16x32_bf16(Bt[n][k], At[m][k], acc[ai][bj][m][n], 0, 0, 0); __builtin_amdgcn_s_setprio(0); } while (0)
#define PG8_WAIT_V(n) asm volatile("s_waitcnt vmcnt(" #n ")" ::: "memory")
#define PG8_WAIT_L(n) asm volatile("s_waitcnt lgkmcnt(" #n ")" ::: "memory")
#define PG8_BAR __builtin_amdgcn_s_barrier()
#define PG8_SCHED __builtin_amdgcn_sched_barrier(0)
    Unit cur, nxt; int ui = 0;
    if (!S.next(0, cur)) return;
    f32x4 acc[2][2][4][2];
#pragma unroll
    for (int a = 0; a < 2; ++a)
#pragma unroll
        for (int b = 0; b < 2; ++b)
#pragma unroll
            for (int m = 0; m < 4; ++m)
#pragma unroll
                for (int n = 0; n < 2; ++n) acc[a][b][m][n] = (f32x4){0.f, 0.f, 0.f, 0.f};
    bf16x8 At[4][2], B0[2][2], B1[2][2];
    const char* cA = (const char*)g.A + (size_t)cur.pm * tstep; const char* cB = (const char*)g.Bt + (size_t)cur.pn * tstep;
    S.a_ready(cur);
    if constexpr (SP2) {
        PG8_STAGE(PG8_SB(0, 0), cB, voffB); PG8_STAGE(PG8_SB(0, 1), cB + hstep, voffB); PG8_STAGE(PG8_SA(0, 0), cA, voffA); PG8_STAGE(PG8_SA(0, 1), cA + hstep, voffA);
        if (wr == 1) PG8_BAR;
        PG8_WAIT_V(2); PG8_BAR;
        PG8_STAGE(PG8_SB(1, 0), cB + kstep, voffB); PG8_STAGE(PG8_SA(1, 0), cA + kstep, voffA); PG8_STAGE(PG8_SB(1, 1), cB + hstep + kstep, voffB);
        PG8_WAIT_V(6); PG8_BAR;
    } else {
        PG8_STAGE(PG8_SB(0, 0), cB, voffB); PG8_STAGE(PG8_SA(0, 0), cA, voffA); PG8_STAGE(PG8_SB(0, 1), cB + hstep, voffB); PG8_STAGE(PG8_SA(0, 1), cA + hstep, voffA);
        if (wr == 1) PG8_BAR;
        PG8_WAIT_V(4); PG8_BAR;
        PG8_STAGE(PG8_SB(1, 0), cB + kstep, voffB); PG8_STAGE(PG8_SA(1, 0), cA + kstep, voffA); PG8_STAGE(PG8_SB(1, 1), cB + hstep + kstep, voffB);
        PG8_WAIT_V(6); PG8_BAR;
    }
    for (;;) {
        const bool has_next = S.next(ui + 1, nxt);
        const char* nA = has_next ? (const char*)g.A + (size_t)nxt.pm * tstep : cA; const char* nB = has_next ? (const char*)g.Bt + (size_t)nxt.pn * tstep : cB;
        for (int t = 0; t < nt; t += 2) {
            const bool last = (t == nt - 2);
            const char* a1 = cA + (size_t)(t + 1) * kstep;
            const char* a2 = last ? nA : cA + (size_t)(t + 2) * kstep; const char* b2 = last ? nB : cB + (size_t)(t + 2) * kstep;
            const char* a3 = a2 + kstep; const char* b3 = b2 + kstep;
            if (last && has_next) S.a_ready(nxt);
            if constexpr (SP2) {
            PG8_LDB(B0, 0, 0); PG8_LDB(B1, 0, 1); PG8_SCHED; PG8_LDA(At, 0, 0); PG8_STAGE(PG8_SA(1, 1), a1 + hstep, voffA);
            PG8_WAIT_V(8); PG8_WAIT_L(0); PG8_BAR; PG8_MMA(0, 0, At, B0); PG8_MMA(0, 1, At, B1); PG8_BAR; PG8_SCHED;
            PG8_LDA(At, 0, 1); PG8_STAGE(PG8_SB(0, 0), b2, voffB); PG8_STAGE(PG8_SB(0, 1), b2 + hstep, voffB); PG8_STAGE(PG8_SA(0, 0), a2, voffA);
            PG8_WAIT_V(8); PG8_WAIT_L(0); PG8_BAR; PG8_MMA(1, 0, At, B0); PG8_MMA(1, 1, At, B1); PG8_BAR; PG8_SCHED;
            PG8_LDB(B0, 1, 0); PG8_LDB(B1, 1, 1); PG8_SCHED; PG8_LDA(At, 1, 0); PG8_STAGE(PG8_SA(0, 1), a2 + hstep, voffA);
            PG8_WAIT_V(8); PG8_WAIT_L(0); PG8_BAR; PG8_MMA(0, 0, At, B0); PG8_MMA(0, 1, At, B1); PG8_BAR; PG8_SCHED;
            PG8_LDA(At, 1, 1); PG8_STAGE(PG8_SB(1, 0), b3, voffB); PG8_STAGE(PG8_SB(1, 1), b3 + hstep, voffB); PG8_STAGE(PG8_SA(1, 0), a3, voffA);
            PG8_WAIT_V(8); PG8_WAIT_L(0); PG8_BAR; PG8_MMA(1, 0, At, B0); PG8_MMA(1, 1, At, B1); PG8_BAR; PG8_SCHED;
            } else {
            PG8_LDB(B0, 0, 0); PG8_SCHED; PG8_LDA(At, 0, 0); PG8_STAGE(PG8_SA(1, 1), a1 + hstep, voffA);
            PG8_WAIT_L(8); PG8_BAR; PG8_WAIT_L(0); PG8_MMA(0, 0, At, B0); PG8_BAR; PG8_SCHED;
            PG8_LDB(B1, 0, 1); PG8_STAGE(PG8_SB(0, 0), b2, voffB);
            PG8_BAR; PG8_WAIT_L(0); PG8_MMA(0, 1, At, B1); PG8_BAR;
            PG8_LDA(At, 0, 1); PG8_STAGE(PG8_SA(0, 0), a2, voffA);
            PG8_BAR; PG8_WAIT_L(0); PG8_MMA(1, 0, At, B0); PG8_BAR; PG8_SCHED;
            PG8_STAGE(PG8_SB(0, 1), b2 + hstep, voffB);
            PG8_WAIT_V(6); PG8_BAR; PG8_MMA(1, 1, At, B1); PG8_BAR;
            PG8_LDB(B0, 1, 0); PG8_SCHED; PG8_LDA(At, 1, 0); PG8_STAGE(PG8_SA(0, 1), a2 + hstep, voffA);
            PG8_WAIT_L(8); PG8_BAR; PG8_WAIT_L(0); PG8_MMA(0, 0, At, B0); PG8_BAR; PG8_SCHED;
            PG8_LDB(B1, 1, 1); PG8_STAGE(PG8_SB(1, 0), b3, voffB);
            PG8_BAR; PG8_WAIT_L(0); PG8_MMA(0, 1, At, B1); PG8_BAR;
            PG8_LDA(At, 1, 1); PG8_STAGE(PG8_SA(1, 0), a3, voffA);
            PG8_BAR; PG8_WAIT_L(0); PG8_MMA(1, 0, At, B0); PG8_BAR; PG8_SCHED;
            PG8_STAGE(PG8_SB(1, 1), b3 + hstep, voffB);
            PG8_WAIT_V(6); PG8_BAR; PG8_MMA(1, 1, At, B1); PG8_BAR;
            }
        }
        if constexpr (ALIGN_EPI) { if (wr == 0) PG8_BAR; }
        if constexpr (!Epi::AFTER_DRAIN) { E(acc, cur, wr, wc, fr, fq); S.done(cur); }
        if (!has_next) break;
#pragma unroll
        for (int a = 0; a < 2; ++a)
#pragma unroll
            for (int b = 0; b < 2; ++b)
#pragma unroll
                for (int m = 0; m < 4; ++m)
#pragma unroll
                    for (int n = 0; n < 2; ++n) acc[a][b][m][n] = (f32x4){0.f, 0.f, 0.f, 0.f};
        cur = nxt; cA = nA; cB = nB; ++ui;
        if constexpr (ALIGN_EPI) { if (wr == 1) PG8_BAR; }
    }
    PG8_WAIT_V(0);
    if constexpr (!ALIGN_EPI) { if (wr == 0) PG8_BAR; }
    PG8_BAR;
    if constexpr (Epi::AFTER_DRAIN) { E.fused(acc, cur, wr, wc, fr, fq, lds, wid, lane); S.done(cur); }
#undef PG8_SA
#undef PG8_SB
#undef PG8_STAGE
#undef PG8_LDA
#undef PG8_LDB
#undef PG8_MMA
#undef PG8_WAIT_V
#undef PG8_WAIT_L
#undef PG8_BAR
#undef PG8_SCHED
}
}

using pg8::bf16_t; using pg8::bf16x8; using pg8::f32x4; using pg8::u32x4; using pg8::Unit; using pg8::Gemm;
#define LAS __attribute__((address_space(3)))
#define TIDX() ({ unsigned z__ = 0u; asm volatile("" : "+v"(z__)); wave_s * 64 + (int)__builtin_amdgcn_mbcnt_hi(~0u, __builtin_amdgcn_mbcnt_lo(~0u, z__)); })
#define XB_TMO      128
#define XB_XCNT(j)  (256  + 64 * (j))
#define XB_XSUB(j)  (1280 + 64 * (j))
#define XB_XGEN(j)  (2304 + 64 * (j))
#define XB_TOP      3328
#define XB_TOPGEN   3392
#define XCD_BAR_WORDS 3456
#define XB_SPIN_CAP (1u << 18)

__device__ __forceinline__ unsigned xb_ld(unsigned* p)              { return __hip_atomic_load(p, __ATOMIC_RELAXED, __HIP_MEMORY_SCOPE_AGENT); }
__device__ __forceinline__ unsigned xb_add(unsigned* p, unsigned v) { return __hip_atomic_fetch_add(p, v, __ATOMIC_RELAXED, __HIP_MEMORY_SCOPE_AGENT); }
__device__ __forceinline__ unsigned xb_xcc_id() { return (unsigned)__builtin_amdgcn_s_getreg((3 << 11) | 20) & 0xFu; }
#define XB_SPIN(cond, bar) do { unsigned _sp = 0; while (cond) { __builtin_amdgcn_s_sleep(1); \
    if ((++_sp & 255u) == 0u) { if (xb_ld(&(bar)[XB_TMO])) break; if (_sp > XB_SPIN_CAP) { atomicAdd(&(bar)[XB_TMO], 1u); break; } } } } while (0)

struct XcdBarrier {
    unsigned* bar; unsigned x;
    volatile LAS unsigned* st;
};

__device__ __forceinline__ XcdBarrier xcd_barrier_post(unsigned* bar, volatile LAS unsigned* st, const int wave_s) {
    XcdBarrier b; b.bar = bar; b.x = xb_xcc_id(); b.st = st;
    if (TIDX() == 0) (void)xb_add(&bar[XB_XCNT(b.x)], 1u);
    return b;
}
__device__ __forceinline__ void xcd_barrier_complete(unsigned* bar, unsigned x, unsigned& nloc, unsigned& nx) {
    const unsigned G = gridDim.x * gridDim.y * gridDim.z;
    unsigned sum, cnt, mine, sp = 0u;
    for (;;) {
        sum = 0u; cnt = 0u; mine = 0u;
#pragma unroll
        for (unsigned j = 0; j < 16; ++j) { const unsigned c = xb_ld(&bar[XB_XCNT(j)]); sum += c; cnt += (c > 0u) ? 1u : 0u; mine = (j == x) ? c : mine; }
        if (sum == G) break;
        __builtin_amdgcn_s_sleep(1);
        if ((++sp & 255u) == 0u) { if (xb_ld(&bar[XB_TMO])) break; if (sp > XB_SPIN_CAP) { atomicAdd(&bar[XB_TMO], 1u); break; } }
    }
    nloc = mine > 0u ? mine : 1u; nx = cnt > 0u ? cnt : 1u;
}

__device__ __forceinline__ void xcd_barrier(const XcdBarrier& b, const int wave_s) {
    asm volatile("s_waitcnt vmcnt(0)" ::: "memory");
    __syncthreads();
    if (TIDX() == 0) {
        unsigned* bar = b.bar;
        __builtin_amdgcn_s_waitcnt(0);
        unsigned nloc = b.st[0], nx = b.st[1];
        if (nloc == 0u) { xcd_barrier_complete(bar, b.x, nloc, nx); b.st[0] = nloc; b.st[1] = nx; }
        const unsigned old = xb_add(&bar[XB_XSUB(b.x)], 1u);
        const unsigned gen = old / nloc;
        if (old + 1u == (gen + 1u) * nloc) {
            __builtin_amdgcn_fence(__ATOMIC_RELEASE, "agent");
            asm volatile("s_waitcnt vmcnt(0)" ::: "memory");
            const unsigned og = xb_add(&bar[XB_TOP], 1u);
            const unsigned tg = og / nx;
            if (og + 1u == (tg + 1u) * nx) xb_add(&bar[XB_TOPGEN], 1u);
            else XB_SPIN(xb_ld(&bar[XB_TOPGEN]) == tg, bar);
            __builtin_amdgcn_fence(__ATOMIC_ACQUIRE, "agent");
            xb_add(&bar[XB_XGEN(b.x)], 1u);
            asm volatile("s_waitcnt vmcnt(0)" ::: "memory");
        } else {
            XB_SPIN(xb_ld(&bar[XB_XGEN(b.x)]) == gen, bar);
            __builtin_amdgcn_fence(__ATOMIC_ACQUIRE, "agent");
            asm volatile("s_waitcnt vmcnt(0)" ::: "memory");
        }
    }
    __syncthreads();
}

typedef float f32x16 __attribute__((ext_vector_type(16)));
typedef unsigned u32x2 __attribute__((ext_vector_type(2)));

constexpr int M_TOK = 32768, DM = 1024, SEQ = 2048, DFF = 2816;
constexpr float EPS = 1e-6f, LOG2E = 1.4426950408889634f;
constexpr size_t MiB = 1u << 20;
constexpr size_t OFF_WGU = 0;
constexpr size_t OFF_WDN = 88 * MiB;
constexpr size_t OFF_WGA = 132 * MiB;
constexpr size_t OFF_WGV = 141 * MiB;
constexpr size_t OFF_WGO = 145 * MiB;
constexpr size_t OFF_WDQK = 149 * MiB;
constexpr size_t OFF_WDV = 157 * MiB;
constexpr size_t OFF_WDO = 161 * MiB;
constexpr size_t OFF_XB = 165 * MiB;
constexpr size_t OFF_SSQ = 229 * MiB;
constexpr size_t OFF_SMALL = 230 * MiB;
constexpr int SM_W2 = 0, SM_BG = 32768, SM_GON = 34816, SM_QKG = 35328, SM_LAM = 35584, SM_SUBG = 36096, SM_TOTAL = 36352;
constexpr size_t OFF_CTL = 230 * MiB + 512 * 1024;
constexpr size_t OFF_BIASM = 231 * MiB;
constexpr size_t OFF_BIG = 232 * MiB;
constexpr size_t BIG_ACT = 0;
constexpr size_t BIG_QK = 0;
constexpr size_t BIG_G = 64 * MiB;
constexpr size_t BIG_VT = 128 * MiB;
constexpr size_t BIG_QE = 192 * MiB;
constexpr size_t BIG_KE = 256 * MiB;
constexpr size_t BIG_KDT = 320 * MiB;
constexpr size_t BIG_LR = 384 * MiB;
constexpr size_t BIG_EBE = 388 * MiB;
constexpr size_t BIG_OBB = 390 * MiB;
constexpr size_t WS_END = OFF_BIG + 454 * MiB;
constexpr int LDS_BYTES = 157696;

typedef float f32x2_t __attribute__((ext_vector_type(2))); typedef __bf16 bf16x2_t __attribute__((ext_vector_type(2)));
__device__ __forceinline__ unsigned cvtpk(float lo, float hi) { f32x2_t v = {lo, hi}; bf16x2_t b = __builtin_convertvector(v, bf16x2_t); return __builtin_bit_cast(unsigned, b); }
__device__ __forceinline__ float bf2f(bf16_t v) { return __uint_as_float(((unsigned)v) << 16); }
__device__ __forceinline__ bf16_t f2bf(float f) { return (bf16_t)(cvtpk(f, 0.f) & 0xffffu); }
typedef unsigned long long u64;
constexpr float SSQ_SCALE = 16777216.f;
__device__ __forceinline__ float row_rstd(const u64* ssq, int row) { return rsqrtf((float)ssq[row] * (1.f / (SSQ_SCALE * 1024.f)) + EPS); }
__device__ __forceinline__ float silu_f(float x) { return x * __builtin_amdgcn_rcpf(1.f + __builtin_amdgcn_exp2f(-x * LOG2E)); }
__device__ __forceinline__ int crow(int r, int hi) { return (r & 3) + 8 * (r >> 2) + 4 * hi; }
#define MFMA32(a, b, c) __builtin_amdgcn_mfma_f32_32x32x16_bf16((a), (b), (c), 0, 0, 0)
#define BAR_LDS() do { asm volatile("s_waitcnt lgkmcnt(0)" ::: "memory"); __builtin_amdgcn_s_barrier(); asm volatile("" ::: "memory"); } while (0)

constexpr int RSTD_LDS_OFF = 131072;
static_assert(RSTD_LDS_OFF + 15 * 1024 <= LDS_BYTES - 64, "rstd slots");
__device__ __forceinline__ void stage_rstd(const pg8::StaticOrder& S, const u64* ssq, LAS unsigned char* ldsb, int swapped, const int wave_s) {
    const int tid = TIDX(); Unit u;
    for (int i = tid >> 8; S.next(i, u); i += 2) { const int row = (swapped ? u.pn : u.pm) * 256 + (tid & 255); ((LAS float*)(ldsb + RSTD_LDS_OFF))[i * 256 + (tid & 255)] = row_rstd(ssq, row); }
    asm volatile("s_waitcnt vmcnt(0) lgkmcnt(0)" ::: "memory"); __builtin_amdgcn_s_barrier(); asm volatile("" ::: "memory");
}
#define RSTD_SLOT(kk_, local_) (((const LAS float*)(ldsb + RSTD_LDS_OFF))[(kk_) * 256 + (local_)])
struct EpiGU { static constexpr bool PERM = true, AFTER_DRAIN = false;
    bf16_t* act; LAS unsigned char* ldsb; mutable int kk;
    __device__ __forceinline__ void operator()(const f32x4 (&acc)[2][2][4][2], const Unit& u, int wr, int wc, int fr, int fq) const {
        const int row0 = u.pm * 256 + wr * 64 + fr, col0 = u.pn * 128 + wc * 32 + 8 * fq;
#pragma unroll
        for (int ai = 0; ai < 2; ++ai)
#pragma unroll
            for (int m = 0; m < 4; ++m) { const int row = row0 + ai * 128 + m * 16; const float rs = RSTD_SLOT(kk, wr * 64 + fr + ai * 128 + m * 16);
                const float c1 = -LOG2E * rs, c2 = rs * rs; f32x2_t o2[4];
#pragma unroll
                for (int n = 0; n < 2; ++n)
#pragma unroll
                    for (int jp = 0; jp < 2; ++jp) { const f32x2_t g2 = {acc[ai][0][m][n][2 * jp], acc[ai][0][m][n][2 * jp + 1]}, u2 = {acc[ai][1][m][n][2 * jp], acc[ai][1][m][n][2 * jp + 1]};
                        const f32x2_t mm = g2 * c1; f32x2_t t; t.x = __builtin_amdgcn_exp2f(mm.x); t.y = __builtin_amdgcn_exp2f(mm.y);
                        const f32x2_t dd = t + 1.f; f32x2_t r; r.x = __builtin_amdgcn_rcpf(dd.x); r.y = __builtin_amdgcn_rcpf(dd.y);
                        o2[n * 2 + jp] = (g2 * u2) * (r * c2); }
                u32x4 w; w.x = cvtpk(o2[0].x, o2[0].y); w.y = cvtpk(o2[1].x, o2[1].y); w.z = cvtpk(o2[2].x, o2[2].y); w.w = cvtpk(o2[3].x, o2[3].y);
                *(u32x4*)(act + (size_t)row * DFF + col0) = w; }
        ++kk;
    }
};
struct EpiRes { static constexpr bool PERM = true, AFTER_DRAIN = false;
    float* fout; bf16_t* xb; u64* ssq; u64* ssq_zero; float alpha; int dry;
    __device__ __forceinline__ void operator()(const f32x4 (&acc)[2][2][4][2], const Unit& u, int wr, int wc, int fr, int fq) const {
        const int row0 = u.pm * 256 + wr * 64 + fr, col0 = u.pn * 256 + wc * 32 + 8 * fq;
#pragma unroll
        for (int ai = 0; ai < 2; ++ai)
#pragma unroll
            for (int m = 0; m < 4; ++m) { const int row = row0 + ai * 128 + m * 16; float ss = 0.f;
#pragma unroll
                for (int bj = 0; bj < 2; ++bj) { const size_t off = (size_t)row * DM + col0 + bj * 128;
                    const u32x4 xo = *(const u32x4*)(xb + off);
                    f32x4 x0, x1;
                    x0[0] = __uint_as_float(xo.x << 16); x0[1] = __uint_as_float(xo.x & 0xffff0000u); x0[2] = __uint_as_float(xo.y << 16); x0[3] = __uint_as_float(xo.y & 0xffff0000u);
                    x1[0] = __uint_as_float(xo.z << 16); x1[1] = __uint_as_float(xo.z & 0xffff0000u); x1[2] = __uint_as_float(xo.w << 16); x1[3] = __uint_as_float(xo.w & 0xffff0000u);
                    x0 = x0 + acc[ai][bj][m][0] * alpha; x1 = x1 + acc[ai][bj][m][1] * alpha;
                    u32x4 w; w.x = cvtpk(x0[0], x0[1]); w.y = cvtpk(x0[2], x0[3]); w.z = cvtpk(x1[0], x1[1]); w.w = cvtpk(x1[2], x1[3]);
                    if (fout) { *(f32x4*)(fout + off) = x0; *(f32x4*)(fout + off + 4) = x1; } else *(u32x4*)(xb + off) = w;
                    ss += ((x0[0] * x0[0] + x0[1] * x0[1]) + (x0[2] * x0[2] + x0[3] * x0[3])) + ((x1[0] * x1[0] + x1[1] * x1[1]) + (x1[2] * x1[2] + x1[3] * x1[3])); }
                ss += __shfl_xor(ss, 16); ss += __shfl_xor(ss, 32);
                if (fq == 0 && !dry && !fout) { atomicAdd(ssq + row, (u64)(ss * SSQ_SCALE)); if (u.pn == 0 && wc == 0) ssq_zero[row] = 0ull; } }
    }
};
struct EpiGlaA { static constexpr bool PERM = true, AFTER_DRAIN = false;
    bf16_t* qk; bf16_t* g; float* lr; LAS unsigned char* ldsb; mutable int kk;
    __device__ __forceinline__ void operator()(const f32x4 (&acc)[2][2][4][2], const Unit& u, int wr, int wc, int fr, int fq) const {
        const int row0 = u.pm * 256 + wr * 64 + fr;
        if (u.pn < 8) {
            bf16_t* base = (u.pn < 4) ? qk : g; const int col0 = (u.pn & 3) * 256 + wc * 32 + 8 * fq;
#pragma unroll
            for (int ai = 0; ai < 2; ++ai)
#pragma unroll
                for (int m = 0; m < 4; ++m) { const int row = row0 + ai * 128 + m * 16; const float rs = RSTD_SLOT(kk, wr * 64 + fr + ai * 128 + m * 16);
#pragma unroll
                    for (int bj = 0; bj < 2; ++bj) { const f32x4 v0 = acc[ai][bj][m][0] * rs, v1 = acc[ai][bj][m][1] * rs;
                        u32x4 w; w.x = cvtpk(v0[0], v0[1]); w.y = cvtpk(v0[2], v0[3]); w.z = cvtpk(v1[0], v1[1]); w.w = cvtpk(v1[2], v1[3]);
                        *(u32x4*)(base + (size_t)row * DM + col0 + bj * 128) = w; } }
        } else if (wc == 0) {
#pragma unroll
            for (int ai = 0; ai < 2; ++ai)
#pragma unroll
                for (int m = 0; m < 4; ++m) { const int row = row0 + ai * 128 + m * 16; const float rs = RSTD_SLOT(kk, wr * 64 + fr + ai * 128 + m * 16);
                    *(f32x4*)(lr + (size_t)row * 32 + 8 * fq) = acc[ai][0][m][0] * rs; *(f32x4*)(lr + (size_t)row * 32 + 8 * fq + 4) = acc[ai][0][m][1] * rs; }
        }
        ++kk;
    }
};
template <int DIFF> struct EpiVt { static constexpr bool PERM = true, AFTER_DRAIN = false;
    bf16_t* vt; LAS unsigned char* ldsb; mutable int kk;
    __device__ __forceinline__ void operator()(const f32x4 (&acc)[2][2][4][2], const Unit& u, int wr, int wc, int fr, int fq) const {
#pragma unroll
        for (int bj = 0; bj < 2; ++bj) { const int tk0 = u.pn * 256 + bj * 128 + wc * 32 + 8 * fq; float rs[8];
#pragma unroll
            for (int e = 0; e < 8; ++e) rs[e] = RSTD_SLOT(kk, bj * 128 + wc * 32 + 8 * fq + e);
            const int b = tk0 >> 11, t = tk0 & 2047;
#pragma unroll
            for (int ai = 0; ai < 2; ++ai)
#pragma unroll
                for (int m = 0; m < 4; ++m) { const int vrow = u.pm * 256 + ai * 128 + wr * 64 + m * 16 + fr;
                    const f32x4 a0 = acc[ai][bj][m][0], a1 = acc[ai][bj][m][1];
                    u32x4 w; w.x = cvtpk(a0[0] * rs[0], a0[1] * rs[1]); w.y = cvtpk(a0[2] * rs[2], a0[3] * rs[3]);
                    w.z = cvtpk(a1[0] * rs[4], a1[1] * rs[5]); w.w = cvtpk(a1[2] * rs[6], a1[3] * rs[7]);
                    size_t addr;
                    if (DIFF) { const int h = vrow >> 7, dv = vrow & 127; addr = ((size_t)(b * 8 + h) * 128 + dv) * 2048 + t; }
                    else { const int h = vrow >> 8, dv = vrow & 255, c = t >> 6, r = t & 63; addr = (((size_t)(b * 32 + c) * 4 + h) * 256 + dv) * 64 + r; }
                    *(u32x4*)(vt + addr) = w; } }
        ++kk;
    }
};
struct EpiQkDiff { static constexpr bool PERM = true, AFTER_DRAIN = false;
    bf16_t* qk; LAS unsigned char* ldsb; const float* gq; const float* gk; mutable int kk;
    __device__ __forceinline__ void operator()(const f32x4 (&acc)[2][2][4][2], const Unit& u, int wr, int wc, int fr, int fq) const {
        const int row0 = u.pm * 256 + wr * 64 + fr; const bool isq = u.pn < 4; const float* gp = isq ? gq : gk; const float sc = isq ? 0.125f * LOG2E : 1.f;
        f32x4 gv[2][2];
#pragma unroll
        for (int bj = 0; bj < 2; ++bj)
#pragma unroll
            for (int n = 0; n < 2; ++n) gv[bj][n] = *(const f32x4*)(gp + 32 * bj + 8 * fq + 4 * n) * sc;
        const int col0 = u.pn * 256 + wc * 64 + 8 * fq;
#pragma unroll
        for (int ai = 0; ai < 2; ++ai)
#pragma unroll
            for (int m = 0; m < 4; ++m) { const int row = row0 + ai * 128 + m * 16; const float rs = RSTD_SLOT(kk, wr * 64 + fr + ai * 128 + m * 16);
                f32x4 v[2][2]; float ss = 0.f;
#pragma unroll
                for (int bj = 0; bj < 2; ++bj)
#pragma unroll
                    for (int n = 0; n < 2; ++n) { v[bj][n] = acc[ai][bj][m][n] * rs; ss += (v[bj][n][0] * v[bj][n][0] + v[bj][n][1] * v[bj][n][1]) + (v[bj][n][2] * v[bj][n][2] + v[bj][n][3] * v[bj][n][3]); }
                ss += __shfl_xor(ss, 16); ss += __shfl_xor(ss, 32);
                const float r2 = rsqrtf(ss * (1.f / 64.f) + EPS);
#pragma unroll
                for (int bj = 0; bj < 2; ++bj) { const f32x4 v0 = v[bj][0] * gv[bj][0] * r2, v1 = v[bj][1] * gv[bj][1] * r2;
                    u32x4 w; w.x = cvtpk(v0[0], v0[1]); w.y = cvtpk(v0[2], v0[3]); w.z = cvtpk(v1[0], v1[1]); w.w = cvtpk(v1[2], v1[3]);
                    *(u32x4*)(qk + (size_t)row * 2048 + col0 + bj * 32) = w; } }
        ++kk;
    }
};

__device__ __forceinline__ unsigned pk2(float lo, float hi) { return cvtpk(lo, hi); }
__device__ __forceinline__ void transpose_item(const float* W, int ldw, int src, int k0, const float* gvec, float scale, bf16_t* dst, int K, LAS float* scr, int lane) {
    const int kr = lane >> 3, n4 = (lane & 7) * 4;
    f32x4 v[8];
#pragma unroll
    for (int i = 0; i < 8; ++i) { v[i] = (f32x4){0.f, 0.f, 0.f, 0.f}; if (src >= 0) v[i] = *(const f32x4*)(W + (size_t)(k0 + 8 * i + kr) * ldw + src + n4); }
#pragma unroll
    for (int i = 0; i < 8; ++i) { const int kk = 8 * i + kr; float gs = scale; if (gvec) gs *= gvec[k0 + kk];
        LAS float* sp = scr + kk * 33 + n4; sp[0] = v[i][0] * gs; sp[1] = v[i][1] * gs; sp[2] = v[i][2] * gs; sp[3] = v[i][3] * gs; }
    asm volatile("s_waitcnt lgkmcnt(0)" ::: "memory");
    const int c = lane & 7;
#pragma unroll
    for (int j = 0; j < 4; ++j) { const int n = (lane >> 3) + 8 * j; const LAS float* s = scr + (8 * c) * 33 + n;
        u32x4 o; o.x = pk2(s[0 * 33], s[1 * 33]); o.y = pk2(s[2 * 33], s[3 * 33]); o.z = pk2(s[4 * 33], s[5 * 33]); o.w = pk2(s[6 * 33], s[7 * 33]);
        *(u32x4*)(dst + (size_t)n * K + k0 + 8 * c) = o; }
    asm volatile("s_waitcnt lgkmcnt(0)" ::: "memory");
}
__device__ __forceinline__ void weight_job(const float* W, int ldw, int K, int nblk, bf16_t* dst, const float* gvec, int type, int coff, LAS float* scr, int gw, int NGW, int lane) {
    const int nkb = K / 64, items = nkb * nblk;
    for (int it = gw; it < items; it += NGW) { const int kb = it / nblk, nb = it % nblk; int src = coff + 32 * nb; float scale = 1.f;
        if (type == 1) { const int pn = nb >> 3, rho = (nb & 7) * 32; src = (rho >> 7) * DFF + 128 * pn + (rho & 127); }
        else if (type == 2) { if (nb < 16) { src = 32 * nb; scale = 0.08838834764831845f; } else if (nb < 32) src = 32 * nb; else if (nb < 64) src = 2048 + 32 * (nb - 32); else if (nb == 64) src = 3072; else src = -1; }
        else if (type == 3) { const int pn = nb >> 3, rho = (nb & 7) * 32, bj = rho >> 7, wc = (rho & 127) >> 5; src = 256 * pn + 64 * wc + 32 * bj; }
        transpose_item(W, ldw, src, kb * 64, gvec, scale, dst + (size_t)nb * 32 * K, K, scr, lane); }
}
__device__ __forceinline__ float wave_sum(float v) {
#pragma unroll
    for (int o = 1; o < 64; o <<= 1) v += __shfl_xor(v, o);
    return v;
}
__device__ __forceinline__ int t5_bucket(int rel) {
    const int n = rel < 0 ? -rel : rel; int bk;
    if (n < 8) bk = n; else bk = n < 12 ? 8 : n < 16 ? 9 : n < 23 ? 10 : n < 32 ? 11 : n < 46 ? 12 : n < 64 ? 13 : n < 91 ? 14 : 15;
    return bk + (rel > 0 ? 16 : 0);
}

__device__ __forceinline__ void gla_prep(LAS unsigned char* lds, const bf16_t* QK, const float* LR, const float* w2, const float* bg, bf16_t* QE, bf16_t* KE, bf16_t* KDT, float* EBE, int vcu, int G, const int wave_s) {
    constexpr int L_Q = 8192, L_K = L_Q + 17408, L_QE = L_K + 17408, L_KE = L_QE + 17408, PQ = 272;
    LAS float* lrs = (LAS float*)lds; LAS float* parts = lrs + 1024;
    int tid_ = TIDX(); asm volatile("" : "+v"(tid_)); const int tid = tid_, d = tid & 127, part = tid >> 7;
    for (int e = vcu; e < 4096; e += G) { const int h = e & 3, c = (e >> 2) & 31, b = (e >> 7) & 15, dir = e >> 11;
        BAR_LDS();
#pragma unroll
        for (int i = 0; i < 2; ++i) { const int idx = tid + 512 * i, r = idx >> 4, k = idx & 15; const int pos = dir ? 2047 - (64 * c + r) : 64 * c + r;
            lrs[idx] = LR[(size_t)(b * 2048 + pos) * 32 + dir * 16 + k];
            const size_t R = (size_t)(b * 2048 + pos) * DM + h * 128 + k * 8;
            *(LAS u32x4*)(lds + L_Q + r * PQ + k * 16) = *(const u32x4*)(QK + R); *(LAS u32x4*)(lds + L_K + r * PQ + k * 16) = *(const u32x4*)(QK + R + 512); }
        float w2c[16];
#pragma unroll
        for (int k = 0; k < 16; ++k) w2c[k] = w2[(dir * 16 + k) * 512 + h * 128 + d];
        const float bias = bg[dir * 512 + h * 128 + d];
        BAR_LDS();
        float pre[16]; float run = 0.f;
#pragma unroll
        for (int i = 0; i < 16; ++i) { const int r = part * 16 + i; float z = bias;
#pragma unroll
            for (int k = 0; k < 16; ++k) z += lrs[r * 16 + k] * w2c[k];
            const float la = (fminf(z, 0.f) - __logf(1.f + __expf(-fabsf(z)))) * (1.f / 16.f);
            run += la; pre[i] = run; }
        parts[part * 128 + d] = run;
        BAR_LDS();
        float off = 0.f, bend = 0.f;
#pragma unroll
        for (int p = 0; p < 4; ++p) { const float v = parts[p * 128 + d]; bend += v; if (p < part) off += v; }
        float kd[16];
        const size_t eb = (size_t)e * 8192;
#pragma unroll
        for (int i = 0; i < 16; ++i) { const int r = part * 16 + i; const float bi = off + pre[i];
            const float q = bf2f(*(const LAS bf16_t*)(lds + L_Q + r * PQ + d * 2)), k = bf2f(*(const LAS bf16_t*)(lds + L_K + r * PQ + d * 2));
            *(LAS bf16_t*)(lds + L_QE + r * PQ + d * 2) = f2bf(q * __expf(bi)); *(LAS bf16_t*)(lds + L_KE + r * PQ + d * 2) = f2bf(k * __expf(-bi)); kd[i] = k * __expf(bend - bi); }
        u32x4 w0, w1;
        if (dir == 0) { w0.x = pk2(kd[0], kd[1]); w0.y = pk2(kd[2], kd[3]); w0.z = pk2(kd[4], kd[5]); w0.w = pk2(kd[6], kd[7]);
                        w1.x = pk2(kd[8], kd[9]); w1.y = pk2(kd[10], kd[11]); w1.z = pk2(kd[12], kd[13]); w1.w = pk2(kd[14], kd[15]);
            *(u32x4*)(KDT + eb + d * 64 + part * 16) = w0; *(u32x4*)(KDT + eb + d * 64 + part * 16 + 8) = w1; }
        else { w0.x = pk2(kd[15], kd[14]); w0.y = pk2(kd[13], kd[12]); w0.z = pk2(kd[11], kd[10]); w0.w = pk2(kd[9], kd[8]);
               w1.x = pk2(kd[7], kd[6]); w1.y = pk2(kd[5], kd[4]); w1.z = pk2(kd[3], kd[2]); w1.w = pk2(kd[1], kd[0]);
            *(u32x4*)(KDT + eb + d * 64 + 48 - part * 16) = w0; *(u32x4*)(KDT + eb + d * 64 + 48 - part * 16 + 8) = w1; }
        if (part == 0) EBE[(size_t)e * 128 + d] = __expf(bend);
        BAR_LDS();
#pragma unroll
        for (int i = 0; i < 2; ++i) { const int idx = tid + 512 * i, r = idx >> 4, k = idx & 15;
            *(u32x4*)(QE + eb + r * 128 + k * 8) = *(const LAS u32x4*)(lds + L_QE + r * PQ + k * 16); *(u32x4*)(KE + eb + r * 128 + k * 8) = *(const LAS u32x4*)(lds + L_KE + r * PQ + k * 16); }
    }
}

__device__ __forceinline__ void gla_scan(LAS unsigned char* lds, const bf16_t* QE, const bf16_t* KE, const bf16_t* KDT, const float* EBE, const bf16_t* VT, bf16_t* OBF, bf16_t* OBB, int vcu, int G, const int wave_s) {
    constexpr int PQ = 272, PT = 144;
    constexpr int L_QE = 0, L_KE = 17408, L_KDT = 34816, L_VT = 53248, L_ST = 71680, L_P = 106496, L_EB = 115712, L_OS = 116224;
    int tid_ = TIDX(); asm volatile("" : "+v"(tid_)); const int tid = tid_, lane = tid & 63, w = __builtin_amdgcn_readfirstlane(tid >> 6), r32 = lane & 31, hi = lane >> 5;
    for (int item = vcu; item < 256; item += G) { const int dvh = item & 1, dir = (item >> 1) & 1, h = (item >> 2) & 3, b = item >> 4;
        BAR_LDS();
        for (int i = tid; i < 34816 / 16; i += 512) ((LAS u32x4*)(lds + L_ST))[i] = (u32x4){0u, 0u, 0u, 0u};
        f32x16 S0, S1;
#pragma unroll
        for (int r = 0; r < 16; ++r) { S0[r] = 0.f; S1[r] = 0.f; }
        bf16_t* OB = dir ? OBB : OBF;
        u32x4 rq[2], rk[2], rd[2], rv[2]; f32x4 re = (f32x4){0.f, 0.f, 0.f, 0.f};
#define GS_LOAD(cc) do { const size_t ei_ = ((size_t)((dir * 16 + b) * 32 + (cc)) * 4 + h); const size_t e_ = ei_ * 8192; const int cf_ = dir ? 31 - (cc) : (cc); \
            const size_t v_ = (((size_t)(b * 32 + cf_) * 4 + h) * 256 + dvh * 128) * 64; \
            _Pragma("unroll") for (int i_ = 0; i_ < 2; ++i_) { const int q_ = tid + 512 * i_; rq[i_] = *(const u32x4*)(QE + e_ + q_ * 8); rk[i_] = *(const u32x4*)(KE + e_ + q_ * 8); \
                rd[i_] = *(const u32x4*)(KDT + e_ + q_ * 8); rv[i_] = *(const u32x4*)(VT + v_ + q_ * 8); } \
            if (tid < 32) re = *(const f32x4*)(EBE + ei_ * 128 + tid * 4); } while (0)
#define CHAIN(acc_, ap_, bp_, NK) do { bf16x8 fa_[NK], fb_[NK]; \
            _Pragma("unroll") for (int ks_ = 0; ks_ < (NK); ++ks_) { fa_[ks_] = *(const LAS bf16x8*)((ap_) + ks_ * 32); fb_[ks_] = *(const LAS bf16x8*)((bp_) + ks_ * 32); } \
            __builtin_amdgcn_sched_barrier(0); \
            _Pragma("unroll") for (int ks_ = 0; ks_ < (NK); ++ks_) acc_ = MFMA32(fa_[ks_], fb_[ks_], acc_); \
            __builtin_amdgcn_sched_barrier(0); } while (0)
        GS_LOAD(0);
        for (int c = 0; c < 32; ++c) {
#pragma unroll
            for (int i = 0; i < 2; ++i) { const int q = tid + 512 * i;
                *(LAS u32x4*)(lds + L_QE + (q >> 4) * PQ + (q & 15) * 16) = rq[i]; *(LAS u32x4*)(lds + L_KE + (q >> 4) * PQ + (q & 15) * 16) = rk[i];
                *(LAS u32x4*)(lds + L_KDT + (q >> 3) * PT + (q & 7) * 16) = rd[i]; *(LAS u32x4*)(lds + L_VT + (q >> 3) * PT + (q & 7) * 16) = rv[i]; }
            if (tid < 32) *(LAS f32x4*)(lds + L_EB + tid * 16) = re;
            BAR_LDS();
            if (c + 1 < 32) GS_LOAD(c + 1);
            if (w < 4) { const int mt = w & 1, nt = w >> 1; f32x16 p;
#pragma unroll
                for (int r = 0; r < 16; ++r) p[r] = 0.f;
                if (!(mt == 1 && nt == 0)) { const LAS unsigned char* ap = lds + L_KE + (mt * 32 + r32) * PQ + hi * 16; const LAS unsigned char* bp = lds + L_QE + (nt * 32 + r32) * PQ + hi * 16;
                    CHAIN(p, ap, bp, 8); }
                const int i = nt * 32 + r32;
#pragma unroll
                for (int g = 0; g < 4; ++g) { const int j0 = mt * 32 + 8 * g + 4 * hi; float v[4];
#pragma unroll
                    for (int e2 = 0; e2 < 4; ++e2) { const int j = j0 + e2; const bool keep = dir ? (j < i) : (j <= i); v[e2] = keep ? p[4 * g + e2] : 0.f; }
                    u32x2 wv; int colp;
                    if (dir == 0) { wv.x = pk2(v[0], v[1]); wv.y = pk2(v[2], v[3]); colp = j0; } else { wv.x = pk2(v[3], v[2]); wv.y = pk2(v[1], v[0]); colp = 60 - j0; }
                    *(LAS u32x2*)(lds + L_P + i * PT + colp * 2) = wv; } }
            const int mtO = w & 1, ntO = w >> 1; f32x16 o;
#pragma unroll
            for (int r = 0; r < 16; ++r) o[r] = 0.f;
            { const LAS unsigned char* ap = lds + L_QE + (mtO * 32 + r32) * PQ + hi * 16; const LAS unsigned char* bp = lds + L_ST + (ntO * 32 + r32) * PQ + hi * 16;
              CHAIN(o, ap, bp, 8); }
            const int dkb = w & 3, dvb = (w >> 2) * 2;
            { const LAS unsigned char* ap = lds + L_KDT + (dkb * 32 + r32) * PT + hi * 16; const LAS unsigned char* bp0 = lds + L_VT + (dvb * 32 + r32) * PT + hi * 16; const LAS unsigned char* bp1 = bp0 + 32 * PT;
              bf16x8 fa[4], fb0[4], fb1[4];
#pragma unroll
              for (int ks = 0; ks < 4; ++ks) { fa[ks] = *(const LAS bf16x8*)(ap + ks * 32); fb0[ks] = *(const LAS bf16x8*)(bp0 + ks * 32); fb1[ks] = *(const LAS bf16x8*)(bp1 + ks * 32); }
              const LAS float* ebp = (const LAS float*)(lds + L_EB) + dkb * 32 + 4 * hi;
#pragma unroll
              for (int g = 0; g < 4; ++g) { const f32x4 e4 = *(const LAS f32x4*)(ebp + 8 * g);
#pragma unroll
                  for (int e2 = 0; e2 < 4; ++e2) { S0[4 * g + e2] *= e4[e2]; S1[4 * g + e2] *= e4[e2]; } }
              __builtin_amdgcn_sched_barrier(0);
#pragma unroll
              for (int ks = 0; ks < 4; ++ks) { S0 = MFMA32(fa[ks], fb0[ks], S0); S1 = MFMA32(fa[ks], fb1[ks], S1); }
              __builtin_amdgcn_sched_barrier(0); }
            BAR_LDS();
            { const LAS unsigned char* ap = lds + L_P + (mtO * 32 + r32) * PT + hi * 16; const LAS unsigned char* bp = lds + L_VT + (ntO * 32 + r32) * PT + hi * 16;
              CHAIN(o, ap, bp, 4);
#pragma unroll
              for (int r = 0; r < 16; ++r) *(LAS bf16_t*)(lds + L_OS + (mtO * 32 + crow(r, hi)) * PQ + (ntO * 32 + r32) * 2) = f2bf(o[r]); }
#pragma unroll
            for (int t = 0; t < 2; ++t) { const int dv = (dvb + t) * 32 + r32;
#pragma unroll
                for (int g = 0; g < 4; ++g) { const int dk0 = dkb * 32 + 8 * g + 4 * hi; u32x2 wv;
                    if (t == 0) { wv.x = pk2(S0[4 * g], S0[4 * g + 1]); wv.y = pk2(S0[4 * g + 2], S0[4 * g + 3]); } else { wv.x = pk2(S1[4 * g], S1[4 * g + 1]); wv.y = pk2(S1[4 * g + 2], S1[4 * g + 3]); }
                    *(LAS u32x2*)(lds + L_ST + dv * PQ + dk0 * 2) = wv; } }
            BAR_LDS();
#pragma unroll
            for (int i = 0; i < 2; ++i) { const int q = tid + 512 * i, row = q >> 4, ch = q & 15; const int pos = dir ? 2047 - (c * 64 + row) : c * 64 + row;
                *(u32x4*)(OB + (size_t)(b * 2048 + pos) * DM + h * 256 + dvh * 128 + ch * 8) = *(const LAS u32x4*)(lds + L_OS + row * PQ + ch * 16); }
        }
#undef CHAIN
#undef GS_LOAD
    }
}

__device__ __forceinline__ void gla_combine(const bf16_t* OBF, const bf16_t* OBB, const bf16_t* GT, const float* gon, bf16_t* AO, int vcu, int G, const int wave_s) {
    int tid_ = TIDX(); asm volatile("" : "+v"(tid_)); const int lane = tid_ & 63, gw = vcu * 8 + __builtin_amdgcn_readfirstlane(tid_ >> 6), NGW = G * 8;
    const int dv0 = (lane & 15) * 16;
    for (int row = gw; row < M_TOK; row += NGW) { const size_t off = (size_t)row * DM + lane * 16;
        u32x4 a[2], bb[2], gg[2];
#pragma unroll
        for (int i = 0; i < 2; ++i) { a[i] = __builtin_nontemporal_load((const u32x4*)(OBF + off + 8 * i)); bb[i] = __builtin_nontemporal_load((const u32x4*)(OBB + off + 8 * i)); gg[i] = __builtin_nontemporal_load((const u32x4*)(GT + off + 8 * i)); }
        float o[16], gt[16]; float ss = 0.f;
#pragma unroll
        for (int i = 0; i < 2; ++i)
#pragma unroll
            for (int k = 0; k < 4; ++k) { const unsigned ua = a[i][k], ub = bb[i][k], ug = gg[i][k];
                const float lo = __uint_as_float(ua << 16) + __uint_as_float(ub << 16), hi2 = __uint_as_float(ua & 0xffff0000u) + __uint_as_float(ub & 0xffff0000u);
                o[i * 8 + 2 * k] = lo; o[i * 8 + 2 * k + 1] = hi2; ss += lo * lo + hi2 * hi2;
                gt[i * 8 + 2 * k] = __uint_as_float(ug << 16); gt[i * 8 + 2 * k + 1] = __uint_as_float(ug & 0xffff0000u); }
        ss += __shfl_xor(ss, 1); ss += __shfl_xor(ss, 2); ss += __shfl_xor(ss, 4); ss += __shfl_xor(ss, 8);
        const float rs = rsqrtf(ss * (1.f / 256.f) + EPS);
        u32x4 wv[2];
#pragma unroll
        for (int i = 0; i < 2; ++i)
#pragma unroll
            for (int k = 0; k < 4; ++k) { const int j = i * 8 + 2 * k; const float y0 = o[j] * rs * gon[dv0 + j] * silu_f(gt[j]), y1 = o[j + 1] * rs * gon[dv0 + j + 1] * silu_f(gt[j + 1]); wv[i][k] = pk2(y0, y1); }
        *(u32x4*)(AO + off) = wv[0]; *(u32x4*)(AO + off + 8) = wv[1];
    }
}

__device__ __forceinline__ void attn_phase(LAS unsigned char* lds, const bf16_t* QK2, const bf16_t* VTd, bf16_t* AO, const float* biasm, float lam, const float* subg, float oml, int vcu, int G, const int wave_s) {
    constexpr int PK = 272, PV = 272  , KST = 34816  , STG = 2 * KST  , L_BT = 2 * STG, L_LS = L_BT + 16384;
    static_assert(L_LS + 1024 <= LDS_BYTES - 64, "attention LDS map");
    LAS float* bt = (LAS float*)(lds + L_BT); LAS float* ls = (LAS float*)(lds + L_LS);
#define SCHED_FENCE() __builtin_amdgcn_sched_barrier(0)
    int h_loaded = -1;
#define AT_LOADB(kb_, vb_, kt, RK, RV) do { _Pragma("unroll") for (int i_ = 0; i_ < 2; ++i_) { const int q_ = tid + 512 * i_; \
            RK[i_] = *(const u32x4*)((kb_) + (unsigned)(((kt) * 64 + (q_ >> 4)) * 2048 + (q_ & 15) * 8)); RV[i_] = *(const u32x4*)((vb_) + (unsigned)((q_ >> 3) * 2048 + (kt) * 64 + (q_ & 7) * 8)); } } while (0)
#define Q_LOAD(b_, h_, q0_) do { _Pragma("unroll") for (int ks = 0; ks < 4; ++ks) qv[ks] = *(const bf16x8*)(QK2 + (size_t)((b_) * 2048 + (q0_) + r32) * 2048 + (h_) * 128 + st * 64 + ks * 16 + hi * 8); } while (0)
    u32x4 rkA[2], rvA[2]; bf16x8 qv[4];
    if (vcu < 2048) { int tid_ = TIDX(); asm volatile("" : "+v"(tid_)); const int tid = tid_, lane = tid & 63, w = __builtin_amdgcn_readfirstlane(tid >> 6), r32 = lane & 31, hi = lane >> 5, st = w >> 2, wq = w & 3;
        const int bh = vcu >> 4, qb = vcu & 15, b = bh >> 3, h = bh & 7;
        AT_LOADB(QK2 + (size_t)(b * 2048) * 2048 + 1024 + h * 128, VTd + (size_t)(b * 8 + h) * 128 * 2048, 0, rkA, rvA); Q_LOAD(b, h, qb * 128 + wq * 32); }
    for (int u = vcu; u < 2048; u += G) { const int bh = u >> 4, qb = u & 15, b = bh >> 3, h = bh & 7;
        int tid_ = TIDX(); asm volatile("" : "+v"(tid_));
        const int tid = tid_, lane = tid & 63, w = __builtin_amdgcn_readfirstlane(tid >> 6), r32 = lane & 31, hi = lane >> 5;
        const int st = w >> 2, wq = w & 3;
        const bool has_next = (u + G) < 2048; const int un = u + G, bhn = un >> 4, bn = bhn >> 3, hn = bhn & 7, q0n = (un & 15) * 128 + wq * 32;
        const bf16_t* kbase_n = QK2 + (size_t)(bn * 2048) * 2048 + 1024 + hn * 128;
        const bf16_t* vbase_n = VTd + (size_t)(bn * 8 + hn) * 128 * 2048;
        BAR_LDS();
        if (h != h_loaded) {
#pragma unroll
            for (int i = 0; i < 8; ++i) bt[tid + 512 * i] = biasm[h * 4096 + tid + 512 * i];
            h_loaded = h; }
        const int q0 = qb * 128 + wq * 32;
        const float cpos = __uint_as_float(__builtin_amdgcn_readfirstlane(__float_as_uint(biasm[h * 4096 + 4094]))), cneg = __uint_as_float(__builtin_amdgcn_readfirstlane(__float_as_uint(biasm[h * 4096])));
        f32x16 o[4];
#pragma unroll
        for (int nt = 0; nt < 4; ++nt)
#pragma unroll
            for (int r = 0; r < 16; ++r) o[nt][r] = 0.f;
        float lsum = 0.f;
        const bf16_t* kbase = QK2 + (size_t)(b * 2048) * 2048 + 1024 + h * 128;
        const bf16_t* vbase = VTd + (size_t)(b * 8 + h) * 128 * 2048;
#define AT_LOAD(kt, RK, RV) AT_LOADB(kbase, vbase, kt, RK, RV)
#define VLOAD(dst, vp_, nt_) do { _Pragma("unroll") for (int s4_ = 0; s4_ < 4; ++s4_) { const u32x2 lo_ = *(const LAS u32x2*)((vp_) + (nt_) * 32 * PV + s4_ * 32), h8_ = *(const LAS u32x2*)((vp_) + (nt_) * 32 * PV + s4_ * 32 + 16); \
            dst[s4_] = (u32x4){lo_.x, lo_.y, h8_.x, h8_.y}; } } while (0)
#define ST_MFMA(kt_, sk_) \
        const int kv0 = (kt_) * 64; const bool farp = (kv0 - (q0 + 31)) >= 91, farn = (q0 - (kv0 + 63)) >= 91; \
        const float cin = farp ? cpos : (farn ? cneg : 0.f); \
        f32x16 p0, p1; \
        _Pragma("unroll") for (int r = 0; r < 16; ++r) { p0[r] = cin; p1[r] = cin; } \
        { const LAS unsigned char* kp = lds + (sk_) + r32 * PK + st * 128 + hi * 16; \
          bf16x8 kf0[4]; \
          _Pragma("unroll") for (int ks = 0; ks < 4; ++ks) kf0[ks] = *(const LAS bf16x8*)(kp + ks * 32); \
          SCHED_FENCE(); \
          _Pragma("unroll") for (int ks = 0; ks < 4; ++ks) kf1[ks] = *(const LAS bf16x8*)(kp + 32 * PK + ks * 32);     \
          _Pragma("unroll") for (int ks = 0; ks < 4; ++ks) p0 = MFMA32(kf0[ks], qv[ks], p0); } \
        SCHED_FENCE();
#define ST_SOFTMAX() \
        if (!(farp || farn)) { const int ib = kv0 + 4 * hi - (q0 + r32) + 2047; \
            _Pragma("unroll") for (int r = 0; r < 16; ++r) { const int idx = ib + (r & 3) + 8 * (r >> 2); p0[r] += bt[idx]; } \
            SCHED_FENCE(); \
            _Pragma("unroll") for (int r = 0; r < 16; ++r) { const int idx = ib + (r & 3) + 8 * (r >> 2); p1[r] += bt[idx + 32]; } } \
        _Pragma("unroll") for (int r = 0; r < 16; ++r) { p0[r] = __builtin_amdgcn_exp2f(p0[r]); p1[r] = __builtin_amdgcn_exp2f(p1[r]); lsum += p0[r] + p1[r]; } \
        _Pragma("unroll") for (int k = 0; k < 4; ++k) { pa[0][k] = pk2(p0[2 * k], p0[2 * k + 1]); pa[1][k] = pk2(p0[8 + 2 * k], p0[8 + 2 * k + 1]); pa[2][k] = pk2(p1[2 * k], p1[2 * k + 1]); pa[3][k] = pk2(p1[8 + 2 * k], p1[8 + 2 * k + 1]); } \
        SCHED_FENCE();
#define PV_REST(vp_) \
        VLOAD(vB, vp_, 1); SCHED_FENCE(); \
        _Pragma("unroll") for (int s4 = 0; s4 < 4; ++s4) o[0] = MFMA32(__builtin_bit_cast(bf16x8, pa[s4]), __builtin_bit_cast(bf16x8, vA[s4]), o[0]); \
        SCHED_FENCE(); VLOAD(vA, vp_, 2); SCHED_FENCE(); \
        _Pragma("unroll") for (int s4 = 0; s4 < 4; ++s4) o[1] = MFMA32(__builtin_bit_cast(bf16x8, pa[s4]), __builtin_bit_cast(bf16x8, vB[s4]), o[1]); \
        SCHED_FENCE(); VLOAD(vB, vp_, 3); SCHED_FENCE(); \
        _Pragma("unroll") for (int s4 = 0; s4 < 4; ++s4) o[2] = MFMA32(__builtin_bit_cast(bf16x8, pa[s4]), __builtin_bit_cast(bf16x8, vA[s4]), o[2]); \
        SCHED_FENCE(); \
        _Pragma("unroll") for (int s4 = 0; s4 < 4; ++s4) o[3] = MFMA32(__builtin_bit_cast(bf16x8, pa[s4]), __builtin_bit_cast(bf16x8, vB[s4]), o[3]); \
        SCHED_FENCE();
#define VCHUNK(dst, c_) do { _Pragma("unroll") for (int nt_ = 0; nt_ < 4; ++nt_) dst[nt_] = *(const LAS u32x4*)(vp + nt_ * 32 * PV + (c_) * 32); } while (0)
#define SMCHUNK(dst, P, B) do { _Pragma("unroll") for (int r_ = 0; r_ < 8; ++r_) { P[(B) + r_] = __builtin_amdgcn_exp2f(P[(B) + r_]); lsum += P[(B) + r_]; } \
            dst = (u32x4){pk2(P[(B)], P[(B) + 1]), pk2(P[(B) + 2], P[(B) + 3]), pk2(P[(B) + 4], P[(B) + 5]), pk2(P[(B) + 6], P[(B) + 7])}; } while (0)
#define PVCHUNK(pa_, v_) do { _Pragma("unroll") for (int nt_ = 0; nt_ < 4; ++nt_) o[nt_] = MFMA32(__builtin_bit_cast(bf16x8, pa_), __builtin_bit_cast(bf16x8, v_[nt_]), o[nt_]); } while (0)
#define INTERLEAVE() do { __builtin_amdgcn_sched_group_barrier(0x100, 4, 0); \
            __builtin_amdgcn_sched_group_barrier(0x008, 1, 0); __builtin_amdgcn_sched_group_barrier(0x002, 6, 0); __builtin_amdgcn_sched_group_barrier(0x008, 1, 0); __builtin_amdgcn_sched_group_barrier(0x002, 6, 0); \
            __builtin_amdgcn_sched_group_barrier(0x008, 1, 0); __builtin_amdgcn_sched_group_barrier(0x002, 6, 0); __builtin_amdgcn_sched_group_barrier(0x008, 1, 0); __builtin_amdgcn_sched_group_barrier(0x002, 6, 0); } while (0)
#define WRITEH(so_, j_, RK, RV) do { _Pragma("unroll") for (int i = 0; i < 2; ++i) { const int q = tid + 512 * i; \
                *(LAS u32x4*)(lds + (so_) + ((j_) * 64 + (q >> 4)) * PK + (q & 15) * 16) = RK[i]; \
                LAS unsigned char* vd = lds + (so_) + KST + (q >> 3) * PV + (j_) * 128 + ((q & 7) >> 1) * 32 + (q & 1) * 8;     \
                *(LAS u32x2*)vd = (u32x2){RV[i].x, RV[i].y}; *(LAS u32x2*)(vd + 16) = (u32x2){RV[i].z, RV[i].w}; } } while (0)
#define SUBTILE(kt_, so_, j_) { \
            const LAS unsigned char* vp = lds + (so_) + KST + r32 * PV + (j_) * 128 + hi * 16; \
            bf16x8 kf1[4]; \
            ST_MFMA(kt_, (so_) + (j_) * 64 * PK) \
            u32x4 vA[4], vB[4]; u32x4 paA, paB; \
            if (!(farp || farn)) { const int ib = kv0 + 4 * hi - (q0 + r32) + 2047; \
                _Pragma("unroll") for (int r = 0; r < 16; ++r) { const int idx = ib + (r & 3) + 8 * (r >> 2); p0[r] += bt[idx]; } SCHED_FENCE(); } \
              \
            SMCHUNK(paA, p0, 0); \
            _Pragma("unroll") for (int ks = 0; ks < 4; ++ks) p1 = MFMA32(kf1[ks], qv[ks], p1); \
            __builtin_amdgcn_sched_group_barrier(0x008, 1, 0); __builtin_amdgcn_sched_group_barrier(0x002, 6, 0); __builtin_amdgcn_sched_group_barrier(0x008, 1, 0); __builtin_amdgcn_sched_group_barrier(0x002, 6, 0); \
            __builtin_amdgcn_sched_group_barrier(0x008, 1, 0); __builtin_amdgcn_sched_group_barrier(0x002, 6, 0); __builtin_amdgcn_sched_group_barrier(0x008, 1, 0); __builtin_amdgcn_sched_group_barrier(0x002, 6, 0); \
            SCHED_FENCE(); \
            VCHUNK(vA, 0); SCHED_FENCE(); \
            if (!(farp || farn)) { const int ib = kv0 + 4 * hi - (q0 + r32) + 2047; \
                _Pragma("unroll") for (int r = 0; r < 16; ++r) { const int idx = ib + (r & 3) + 8 * (r >> 2); p1[r] += bt[idx + 32]; } SCHED_FENCE(); } \
            VCHUNK(vB, 1); SMCHUNK(paB, p0, 8); PVCHUNK(paA, vA); INTERLEAVE(); SCHED_FENCE(); \
            VCHUNK(vA, 2); SMCHUNK(paA, p1, 0); PVCHUNK(paB, vB); INTERLEAVE(); SCHED_FENCE(); \
            VCHUNK(vB, 3); SMCHUNK(paB, p1, 8); PVCHUNK(paA, vA); INTERLEAVE(); SCHED_FENCE(); \
            PVCHUNK(paB, vB); SCHED_FENCE(); }
        WRITEH(0, 0, rkA, rvA); AT_LOAD(1, rkA, rvA); WRITEH(0, 1, rkA, rvA);
        if (w >= 4) __builtin_amdgcn_s_setprio(1);
        for (int T = 0; T < 16; ++T) { const int so = (T & 1) * STG, sn = STG - so;
            BAR_LDS();
            if (T + 1 < 16) AT_LOAD(2 * T + 2, rkA, rvA); else if (has_next) AT_LOADB(kbase_n, vbase_n, 0, rkA, rvA);
            SUBTILE(2 * T, so, 0)
            if (T + 1 < 16) { WRITEH(sn, 0, rkA, rvA); AT_LOAD(2 * T + 3, rkA, rvA); }
            SUBTILE(2 * T + 1, so, 1)
            if (T + 1 < 16) WRITEH(sn, 1, rkA, rvA);
        }
        __builtin_amdgcn_s_setprio(0);
        if (has_next) Q_LOAD(bn, hn, q0n);
#undef VCHUNK
#undef SMCHUNK
#undef PVCHUNK
#undef INTERLEAVE
#undef SUBTILE
#undef WRITEH
#undef AT_LOAD
#undef VLOAD
#undef ST_MFMA
#undef ST_SOFTMAX
#undef PV_REST
        lsum += __shfl_xor(lsum, 32);
        if (hi == 0) ls[w * 32 + r32] = lsum;
        BAR_LDS();
        float rl[16];
#pragma unroll
        for (int r = 0; r < 16; ++r) rl[r] = __builtin_amdgcn_rcpf(ls[w * 32 + crow(r, hi)]);
        LAS float* o2 = (LAS float*)lds;
        if (st == 1) {
#pragma unroll
            for (int nt = 0; nt < 4; ++nt)
#pragma unroll
                for (int r = 0; r < 16; ++r) o2[(wq * 32 + crow(r, hi)) * 128 + nt * 32 + r32] = o[nt][r] * rl[r] * lam; }
        BAR_LDS();
        if (st == 0) {
#pragma unroll
            for (int r = 0; r < 16; ++r) { const int ql = wq * 32 + crow(r, hi);
#pragma unroll
                for (int nt = 0; nt < 4; ++nt) o[nt][r] = o[nt][r] * rl[r] - o2[ql * 128 + nt * 32 + r32]; } }
        BAR_LDS();
        if (st == 0) { float gsub[4];
#pragma unroll
            for (int nt = 0; nt < 4; ++nt) gsub[nt] = subg[nt * 32 + r32] * oml;
#pragma unroll
            for (int r = 0; r < 16; ++r) { const int ql = wq * 32 + crow(r, hi); float ss = 0.f;
#pragma unroll
                for (int nt = 0; nt < 4; ++nt) ss += o[nt][r] * o[nt][r];
                ss += __shfl_xor(ss, 1); ss += __shfl_xor(ss, 2); ss += __shfl_xor(ss, 4); ss += __shfl_xor(ss, 8); ss += __shfl_xor(ss, 16);
                const float rs = rsqrtf(ss * (1.f / 128.f) + EPS);
                LAS bf16_t* srow = (LAS bf16_t*)lds + ql * 136 + r32;
#pragma unroll
                for (int nt = 0; nt < 4; ++nt) srow[nt * 32] = f2bf(o[nt][r] * rs * gsub[nt]); } }
        BAR_LDS();
        { bf16_t* obase = AO + (size_t)(b * 2048 + qb * 128) * DM + h * 128;
#pragma unroll
          for (int i = 0; i < 4; ++i) { const int pc = tid + 512 * i, row = pc >> 4, ch = pc & 15;
              const LAS u32x2* sp = (const LAS u32x2*)((LAS bf16_t*)lds + row * 136 + ch * 8); const u32x2 a0 = sp[0], a1 = sp[1];
              *(u32x4*)(obase + (size_t)row * DM + ch * 8) = (u32x4){a0.x, a0.y, a1.x, a1.y}; } }
    }
}

struct Params { const float* in[15]; float* out; unsigned char* ws; };

__global__ void __launch_bounds__(512) mega_fwd(Params p) {
    extern __shared__ __attribute__((aligned(16))) unsigned char lds_raw[];
    LAS unsigned char* lds = (LAS unsigned char*)lds_raw;
    cg::grid_group grid = cg::this_grid();
#define GRID_SYNC() do { asm volatile("s_waitcnt vmcnt(0)" ::: "memory"); grid.sync(); __builtin_amdgcn_fence(__ATOMIC_ACQUIRE, "agent"); asm volatile("s_waitcnt vmcnt(0)" ::: "memory"); } while (0)
    const int wave_s = __builtin_amdgcn_readfirstlane(threadIdx.x >> 6);
    const int G = gridDim.x, bx = blockIdx.x; const int vcu = (G % 8 == 0) ? (bx % 8) * (G / 8) + bx / 8 : bx;
#define WS_PTRS() size_t wz_ = 0; asm volatile("" : "+s"(wz_)); unsigned char* ws = p.ws + wz_;     \
    unsigned char* big = ws + OFF_BIG; const float* SMALLP = (const float*)(ws + OFF_SMALL); (void)big; (void)SMALLP

#ifdef POISON_WORD
    {
        WS_PTRS();
        u32x4* pz = (u32x4*)(ws + OFF_XB); const size_t n16 = (WS_END - OFF_XB) / 16;
        for (size_t i = (size_t)bx * 512 + TIDX(); i < n16; i += (size_t)G * 512) pz[i] = (u32x4){POISON_WORD, POISON_WORD, POISON_WORD, POISON_WORD};
    }
    GRID_SYNC();
#endif
    volatile LAS unsigned* bst = (volatile LAS unsigned*)(lds + LDS_BYTES - 64);
    if (TIDX() < 2) bst[TIDX()] = 0u;
    __syncthreads();
    XcdBarrier xbar = xcd_barrier_post((unsigned*)(p.ws + OFF_CTL), bst, wave_s);
#define XCD_SYNC() do { XcdBarrier xb2_ = xbar; size_t bz_ = 0; asm volatile("" : "+s"(bz_), "+s"(xb2_.x)); xb2_.bar = (unsigned*)(p.ws + OFF_CTL + bz_); xcd_barrier(xb2_, wave_s); } while (0)
    {
        WS_PTRS();
        int tid_ = TIDX(); asm volatile("" : "+v"(tid_)); const int tid = tid_, lane = tid & 63, wave = __builtin_amdgcn_readfirstlane(tid >> 6);
        const int gw = vcu * 8 + wave, NGW = G * 8;
        const float* x_in = p.in[0]; const float* norm_g = p.in[1]; const float* w_gu = p.in[2]; const float* w_dn = p.in[3];
        const float* gla_w_in = p.in[4]; const float* gla_w_out = p.in[8]; const float* diff_w_in = p.in[9]; const float* diff_qkg = p.in[10]; const float* diff_w_out = p.in[13]; const float* rel_tab = p.in[14];
        bf16_t* WGU = (bf16_t*)(ws + OFF_WGU); bf16_t* WDN = (bf16_t*)(ws + OFF_WDN); bf16_t* WGA = (bf16_t*)(ws + OFF_WGA); bf16_t* WGV = (bf16_t*)(ws + OFF_WGV); bf16_t* WGO = (bf16_t*)(ws + OFF_WGO);
        bf16_t* WDQK = (bf16_t*)(ws + OFF_WDQK); bf16_t* WDV = (bf16_t*)(ws + OFF_WDV); bf16_t* WDO = (bf16_t*)(ws + OFF_WDO);
        bf16_t* XB = (bf16_t*)(ws + OFF_XB); u64* SSQ = (u64*)(ws + OFF_SSQ); float* BIASM = (float*)(ws + OFF_BIASM); float* SMALLW = (float*)(ws + OFF_SMALL);
        LAS float* scr = (LAS float*)(lds + wave * 16384);
#ifndef REP_P0
#define REP_P0 1
#endif
        for (int rep_ = 0; rep_ < REP_P0; ++rep_) {
        for (int gi = gw; gi < 42240; gi += NGW) {
            const float* W; int ldw, K, nblk, type = 0, coff = 0, r; bf16_t* dst; const float* gv = nullptr;
            if (gi < 33792) { const int lf = gi / 4224, l = lf >> 1, f = lf & 1; r = gi % 4224;
                if (r < 2816) { W = w_gu + (size_t)lf * DM * 2 * DFF; ldw = 2 * DFF; K = DM; nblk = 176; dst = WGU + (size_t)lf * 2 * DFF * DM; gv = norm_g + (l * 3 + (f ? 2 : 0)) * DM; type = 1; }
                else { r -= 2816; W = w_dn + (size_t)lf * DFF * DM; ldw = DM; K = DFF; nblk = 32; dst = WDN + (size_t)lf * DM * DFF; }
            } else { const int g2 = gi - 33792, j = g2 / 4224; r = g2 % 4224;
                if (r < 1152) { W = gla_w_in + (size_t)j * DM * 3104; ldw = 3104; K = DM; nblk = 72; dst = WGA + (size_t)j * 2304 * DM; gv = norm_g + ((2 * j) * 3 + 1) * DM; type = 2; }
                else if (r < 1664) { r -= 1152; W = gla_w_in + (size_t)j * DM * 3104; ldw = 3104; K = DM; nblk = 32; dst = WGV + (size_t)j * DM * DM; gv = norm_g + ((2 * j) * 3 + 1) * DM; coff = 1024; }
                else if (r < 2176) { r -= 1664; W = gla_w_out + (size_t)j * DM * DM; ldw = DM; K = DM; nblk = 32; dst = WGO + (size_t)j * DM * DM; }
                else if (r < 3200) { r -= 2176; W = diff_w_in + (size_t)j * DM * 3072; ldw = 3072; K = DM; nblk = 64; dst = WDQK + (size_t)j * 2048 * DM; gv = norm_g + ((2 * j + 1) * 3 + 1) * DM; type = 3; }
                else if (r < 3712) { r -= 3200; W = diff_w_in + (size_t)j * DM * 3072; ldw = 3072; K = DM; nblk = 32; dst = WDV + (size_t)j * DM * DM; gv = norm_g + ((2 * j + 1) * 3 + 1) * DM; coff = 2048; }
                else { r -= 3712; W = diff_w_out + (size_t)j * DM * DM; ldw = DM; K = DM; nblk = 32; dst = WDO + (size_t)j * DM * DM; } }
            const int kb = r / nblk, nb = r % nblk; int src = coff + 32 * nb; float scale = 1.f;
            if (type == 1) { const int pn = nb >> 3, rho = (nb & 7) * 32; src = (rho >> 7) * DFF + 128 * pn + (rho & 127); }
            else if (type == 2) { if (nb < 16) { src = 32 * nb; scale = 0.08838834764831845f; } else if (nb < 32) src = 32 * nb; else if (nb < 64) src = 2048 + 32 * (nb - 32); else if (nb == 64) src = 3072; else src = -1; }
            else if (type == 3) { const int pn = nb >> 3, rho = (nb & 7) * 32, bj = rho >> 7, wc = (rho & 127) >> 5; src = 256 * pn + 64 * wc + 32 * bj; }
            transpose_item(W, ldw, src, kb * 64, gv, scale, dst + (size_t)nb * 32 * K, K, scr, lane);
        }
        }
        for (int m = gw; m < M_TOK; m += NGW) { const f32x4* xr = (const f32x4*)(x_in + (size_t)m * DM) + lane; u32x2* xbo = (u32x2*)(XB + (size_t)m * DM) + lane;
            float s = 0.f;
#pragma unroll
            for (int jj = 0; jj < 4; ++jj) { const f32x4 v = xr[64 * jj]; u32x2 wv; wv.x = pk2(v[0], v[1]); wv.y = pk2(v[2], v[3]); xbo[64 * jj] = wv; s += (v[0] * v[0] + v[1] * v[1]) + (v[2] * v[2] + v[3] * v[3]); }
            s = wave_sum(s);
            if (lane == 0) { SSQ[m] = (u64)(s * SSQ_SCALE); SSQ[M_TOK + m] = 0ull; } }
        for (int idx = bx * 512 + tid; idx < SM_TOTAL; idx += G * 512) { float v;
            if (idx < SM_BG) v = p.in[5][idx]; else if (idx < SM_GON) v = p.in[6][idx - SM_BG]; else if (idx < SM_QKG) v = p.in[7][idx - SM_GON];
            else if (idx < SM_LAM) v = p.in[10][idx - SM_QKG]; else if (idx < SM_SUBG) v = p.in[11][idx - SM_LAM]; else v = p.in[12][idx - SM_SUBG];
            SMALLW[idx] = v; }
        for (int idx = bx * 512 + tid; idx < 2 * 8 * 4096; idx += G * 512) { const int j = idx >> 15, h = (idx >> 12) & 7, ri = idx & 4095;
            float mq = 0.f, mk = 0.f, mb = 0.f;
            for (int d = 0; d < 64; ++d) { mq = fmaxf(mq, fabsf(diff_qkg[(j * 2 + 0) * 64 + d])); mk = fmaxf(mk, fabsf(diff_qkg[(j * 2 + 1) * 64 + d])); }
            for (int bk = 0; bk < 32; ++bk) mb = fmaxf(mb, fabsf(rel_tab[bk * 8 + h]));
            const float smax = 8.f * mq * mk + mb; const int rel = ri - 2047;
            BIASM[idx] = (ri < 4095) ? (rel_tab[t5_bucket(rel) * 8 + h] - smax) * LOG2E : 0.f; }
    }
    if (p.ws == nullptr) GRID_SYNC();
    XCD_SYNC();

    #ifndef REP_INPROJ
#define REP_INPROJ 1
#endif
    int resk = 0;
    for (int layer_i = 0; layer_i < 4; ++layer_i) {
        for (int step = 0; step < 10; ++step) {
#ifdef MAXSTEP
            if (layer_i * 10 + step >= MAXSTEP) break;
#endif
            int layer = layer_i; asm volatile("" : "+s"(layer));
            const int j = layer >> 1; const bool is_gla = (layer & 1) == 0;
            bool sync_after = true;
            if (step == 0 || step == 8) { WS_PTRS(); const int lf = layer * 2 + (step == 8 ? 1 : 0);
                Gemm g{(const bf16_t*)(ws + OFF_XB), (const bf16_t*)(ws + OFF_WGU) + (size_t)lf * 2 * DFF * DM, M_TOK, 2 * DFF, DM}; pg8::StaticOrder S; S.init(M_TOK, 2 * DFF, G, bx);
                stage_rstd(S, (const u64*)(ws + OFF_SSQ) + (size_t)(resk & 1) * M_TOK, lds, 0, wave_s);
                EpiGU E{(bf16_t*)(big + BIG_ACT), lds, 0};

#ifndef NO_GU
#ifndef REP_GU
#define REP_GU 1
#endif
for (int rep_ = 0; rep_ < REP_GU; ++rep_) pg8::gemm_phase<EpiGU, pg8::StaticOrder, true, true>(lds, g, S, E, wave_s);
#endif

            } else if (step == 1 || step == 7 || step == 9) { WS_PTRS();
                Gemm g; float alpha;
                if (step == 7) { g = Gemm{(const bf16_t*)(big + BIG_QE), (const bf16_t*)(ws + (is_gla ? OFF_WGO : OFF_WDO)) + (size_t)j * DM * DM, M_TOK, DM, DM}; alpha = 1.f; }
                else { const int lf = layer * 2 + (step == 9 ? 1 : 0); g = Gemm{(const bf16_t*)(big + BIG_ACT), (const bf16_t*)(ws + OFF_WDN) + (size_t)lf * DM * DFF, M_TOK, DM, DFF}; alpha = 0.5f; }
                pg8::StaticOrder S; S.init(M_TOK, DM, G, bx);
                float* xres = nullptr; if (layer == 3 && step == 9) { size_t oz_ = 0; asm volatile("" : "+s"(oz_)); xres = p.out + oz_; }
                EpiRes E{xres, (bf16_t*)(ws + OFF_XB), (u64*)(ws + OFF_SSQ) + (size_t)((resk + 1) & 1) * M_TOK, (u64*)(ws + OFF_SSQ) + (size_t)(resk & 1) * M_TOK, alpha, 0};

#ifndef NO_RES
#ifdef REP_DN
 if (step != 7) { EpiRes E2 = E; E2.alpha = 0.f; E2.dry = 1; pg8::gemm_phase<EpiRes, pg8::StaticOrder, true, true>(lds, g, S, E2, wave_s); }
#endif
pg8::gemm_phase<EpiRes, pg8::StaticOrder, true, true>(lds, g, S, E, wave_s);
#endif

                ++resk;
            } else if (step == 2) { WS_PTRS(); sync_after = is_gla; const u64* ssq = (const u64*)(ws + OFF_SSQ) + (size_t)(resk & 1) * M_TOK;
                if (is_gla) { Gemm g{(const bf16_t*)(ws + OFF_XB), (const bf16_t*)(ws + OFF_WGA) + (size_t)j * 2304 * DM, M_TOK, 2304, DM}; pg8::StaticOrder S; S.init(M_TOK, 2304, G, bx);
                    stage_rstd(S, ssq, lds, 0, wave_s);
                    EpiGlaA E{(bf16_t*)(big + BIG_QK), (bf16_t*)(big + BIG_G), (float*)(big + BIG_LR), lds, 0};

#ifndef NO_GLAA
for (int rep_ = 0; rep_ < REP_INPROJ; ++rep_) pg8::gemm_phase<EpiGlaA, pg8::StaticOrder, true, true>(lds, g, S, E, wave_s);
#endif

                } else { Gemm g{(const bf16_t*)(ws + OFF_XB), (const bf16_t*)(ws + OFF_WDQK) + (size_t)j * 2048 * DM, M_TOK, 2048, DM}; pg8::StaticOrder S; S.init(M_TOK, 2048, G, bx);
                    stage_rstd(S, ssq, lds, 0, wave_s);
                    EpiQkDiff E{(bf16_t*)(big + BIG_QK), lds, SMALLP + SM_QKG + (j * 2 + 0) * 64, SMALLP + SM_QKG + (j * 2 + 1) * 64, 0};

#ifndef NO_QKD
for (int rep_ = 0; rep_ < REP_INPROJ; ++rep_) pg8::gemm_phase<EpiQkDiff, pg8::StaticOrder, true, true>(lds, g, S, E, wave_s);
#endif
 }
            } else if (step == 3) { WS_PTRS(); sync_after = !is_gla; const u64* ssq = (const u64*)(ws + OFF_SSQ) + (size_t)(resk & 1) * M_TOK;
                if (is_gla) { Gemm g{(const bf16_t*)(ws + OFF_WGV) + (size_t)j * DM * DM, (const bf16_t*)(ws + OFF_XB), DM, M_TOK, DM}; pg8::StaticOrder S; S.init(DM, M_TOK, G, bx);
                    stage_rstd(S, ssq, lds, 1, wave_s);
                    EpiVt<0> E{(bf16_t*)(big + BIG_VT), lds, 0};

#ifndef NO_VT0
for (int rep_ = 0; rep_ < REP_INPROJ; ++rep_) pg8::gemm_phase<EpiVt<0>, pg8::StaticOrder, true, true>(lds, g, S, E, wave_s);
#endif

                } else { Gemm g{(const bf16_t*)(ws + OFF_WDV) + (size_t)j * DM * DM, (const bf16_t*)(ws + OFF_XB), DM, M_TOK, DM}; pg8::StaticOrder S; S.init(DM, M_TOK, G, bx);
                    stage_rstd(S, ssq, lds, 1, wave_s);
                    EpiVt<1> E{(bf16_t*)(big + BIG_VT), lds, 0};

#ifndef NO_VT1
for (int rep_ = 0; rep_ < REP_INPROJ; ++rep_) pg8::gemm_phase<EpiVt<1>, pg8::StaticOrder, true, true>(lds, g, S, E, wave_s);
#endif
 }
            } else if (step == 4) { WS_PTRS();

#ifndef NO_PREP
#ifndef REP_PREP
#define REP_PREP 1
#endif
if (is_gla) for (int rep_ = 0; rep_ < REP_PREP; ++rep_) gla_prep(lds, (const bf16_t*)(big + BIG_QK), (const float*)(big + BIG_LR), SMALLP + SM_W2 + (size_t)j * 2 * 16 * 512, SMALLP + SM_BG + j * 2 * 512,
                                     (bf16_t*)(big + BIG_QE), (bf16_t*)(big + BIG_KE), (bf16_t*)(big + BIG_KDT), (float*)(big + BIG_EBE), vcu, G, wave_s);
#else
if(0){}
#endif
                else { const float* lv = SMALLP + SM_LAM + j * 256; float s01 = 0.f, s23 = 0.f;
                    for (int d = 0; d < 64; ++d) { s01 += lv[d] * lv[64 + d]; s23 += lv[128 + d] * lv[192 + d]; }
                    const float lam_init = (layer == 1) ? 0.35550906759096926f : 0.5560582041556405f;     const float lam = __expf(s01) - __expf(s23) + lam_init;

#ifndef NO_ATTN
#ifndef REP_ATTN
#define REP_ATTN 1
#endif
 for (int rep_ = 0; rep_ < REP_ATTN; ++rep_) attn_phase(lds, (const bf16_t*)(big + BIG_QK), (const bf16_t*)(big + BIG_VT), (bf16_t*)(big + BIG_QE), (const float*)(ws + OFF_BIASM) + (size_t)j * 8 * 4096, lam, SMALLP + SM_SUBG + j * 128, 1.f - lam_init, vcu, G, wave_s);
#endif
 }
            } else if (step == 5) {

#ifndef NO_SCAN
#ifndef REP_SCAN
#define REP_SCAN 1
#endif
if (is_gla) { WS_PTRS(); for (int rep_ = 0; rep_ < REP_SCAN; ++rep_) gla_scan(lds, (const bf16_t*)(big + BIG_QE), (const bf16_t*)(big + BIG_KE), (const bf16_t*)(big + BIG_KDT), (const float*)(big + BIG_EBE), (const bf16_t*)(big + BIG_VT),
                                                  (bf16_t*)(big + BIG_QK), (bf16_t*)(big + BIG_OBB), vcu, G, wave_s); } else
#endif
 sync_after = false;
            } else if (step == 6) {

#ifndef NO_COMB
#ifndef REP_COMB
#define REP_COMB 1
#endif
if (is_gla) { WS_PTRS(); for (int rep_ = 0; rep_ < REP_COMB; ++rep_) gla_combine((const bf16_t*)(big + BIG_QK), (const bf16_t*)(big + BIG_OBB), (const bf16_t*)(big + BIG_G), SMALLP + SM_GON + j * 256, (bf16_t*)(big + BIG_QE), vcu, G, wave_s); } else
#endif
 sync_after = false;
            }
            if (sync_after && !(layer == 3 && step == 9)) XCD_SYNC();
        }
    }
}

extern "C" void kernel_launch(void* const* d_in, const int* in_sizes, int n_in, void* d_out, int out_size, void* d_ws, size_t ws_size, hipStream_t stream) {
    static int grid_blocks = 0;
    if (grid_blocks == 0) {
        if (n_in != 15 || out_size != M_TOK * DM || ws_size < WS_END) { fprintf(stderr, "kernel_launch: unexpected shapes (n_in %d out %d ws %zu need %zu)\n", n_in, out_size, ws_size, (size_t)WS_END); grid_blocks = -1; return; }
        int dev = 0, cus = 0, per_cu = 0;
        hipGetDevice(&dev); hipDeviceGetAttribute(&cus, hipDeviceAttributeMultiprocessorCount, dev);
        if (hipFuncSetAttribute((const void*)mega_fwd, hipFuncAttributeMaxDynamicSharedMemorySize, LDS_BYTES) != hipSuccess) { fprintf(stderr, "kernel_launch: hipFuncSetAttribute failed\n"); grid_blocks = -1; return; }
        if (hipOccupancyMaxActiveBlocksPerMultiprocessor(&per_cu, (const void*)mega_fwd, 512, LDS_BYTES) != hipSuccess || per_cu < 1) { fprintf(stderr, "kernel_launch: occupancy query gave %d\n", per_cu); per_cu = 1; }
        (void)hipGetLastError();
        grid_blocks = cus * 1;
        if (grid_blocks < 188) { fprintf(stderr, "kernel_launch: %d CUs: the per-unit rstd tables in LDS hold at most 15 GEMM units per workgroup (needs >= 188 workgroups); nothing launched\n", grid_blocks); grid_blocks = -1; return; }
    }
    if (grid_blocks < 0) return;
    if (hipMemsetAsync((char*)d_ws + OFF_CTL, 0, 16384, stream) != hipSuccess) { fprintf(stderr, "kernel_launch: memset of the barrier words failed\n"); return; }
    Params p{};
    for (int i = 0; i < 15; ++i) p.in[i] = (const float*)d_in[i];
    p.out = (float*)d_out; p.ws = (unsigned char*)d_ws;
    void* args[] = {&p};
    hipError_t e = hipLaunchCooperativeKernel((const void*)mega_fwd, dim3(grid_blocks), dim3(512), args, LDS_BYTES, stream);
    if (e != hipSuccess) fprintf(stderr, "cooperative launch failed: %s (grid %d)\n", hipGetErrorString(e), grid_blocks);
}
```

```cpp
#include <hip/hip_runtime.h>
#include <hip/hip_cooperative_groups.h>
#include <cstdio>
#include <cstdint>
namespace cg = cooperative_groups;
namespace pg8 {
#define PG8_LAS __attribute__((address_space(3)))
typedef unsigned short bf16_t;
typedef short bf16x8 __attribute__((ext_vector_type(8)));
typedef float f32x4 __attribute__((ext_vector_type(4)));
typedef unsigned u32x4 __attribute__((ext_vector_type(4)));
constexpr int BM = 256, BK = 64, HALF = 128, HTB = HALF * BK * 2  , STAGE_BYTES = 8 * HTB, NXCD = 8, WGM = 8;

__host__ __device__ __forceinline__ int lds_byte(int r, int c) { const int st = (r >> 4) * 2 + (c >> 5), rr = r & 15, cc = c & 31, ob = rr * 64 + cc * 2; return st * 1024 + (ob ^ (((ob >> 9) & 1) << 5)); }
__host__ __device__ __forceinline__ void stage_rc(int b, int& R, int& C) { const int st = b / 1024, sb = b % 1024, swz = sb ^ (((sb >> 9) & 1) << 5); R = (st >> 1) * 16 + swz / 64; C = (st & 1) * 32 + (swz % 64) / 2; }
__host__ __device__ __forceinline__ int perm32(int rho) { const int n = rho >> 4, i = rho & 15; return 8 * (i >> 2) + 4 * n + (i & 3); }

struct Unit { int pm, pn; };
struct Gemm { const bf16_t* A; const bf16_t* Bt; int M, N, K; };

struct StaticOrder {
    int nM, nN, nwg, G, c;
    __host__ __device__ void init(int M, int N, int G_, int c_) { nM = M / BM; nN = N / BM; nwg = nM * nN; G = G_; c = c_; }
    __host__ __device__ bool next(int i, Unit& u) const {
        const long L = (long)i * G + c; if (L >= nwg) return false;
        int wgid = (int)L; { const int q = nwg / NXCD, r = nwg % NXCD, xcd = wgid % NXCD, off = wgid / NXCD; wgid = (xcd < r ? xcd * (q + 1) : r * (q + 1) + (xcd - r) * q) + off; }
        const int nig = WGM * nN, gid = wgid / nig, fm = gid * WGM, gsz = (nM - fm) < WGM ? (nM - fm) : WGM;
        u.pm = fm + ((wgid % nig) % gsz); u.pn = (wgid % nig) / gsz; return true;
    }
    __device__ __forceinline__ void a_ready(const Unit&) const {}
    __device__ __forceinline__ void done(const Unit&) const {}
};
__device__ __forceinline__ unsigned cvt_pk_bf16(float lo, float hi) { unsigned r; asm volatile("v_cvt_pk_bf16_f32 %0, %1, %2" : "=v"(r) : "v"(lo), "v"(hi)); return r; }
template <class Epi, class Sched, bool ALIGN_EPI = false, bool SP2 = false>
__device__ __forceinline__ void gemm_phase(PG8_LAS unsigned char* lds, const Gemm g, const Sched& S, const Epi& E, const int wave_s) {
    unsigned z_ = 0u; asm volatile("" : "+v"(z_)); int tid_ = wave_s * 64 + (int)__builtin_amdgcn_mbcnt_hi(~0u, __builtin_amdgcn_mbcnt_lo(~0u, z_)); asm volatile("" : "+v"(tid_)); const int tid = tid_, wid = __builtin_amdgcn_readfirstlane(tid >> 6), lane = tid & 63, wr = wid >> 2, wc = wid & 3, fr = lane & 15, fq = lane >> 4;
    const int K = g.K, nt = K / BK;
    unsigned voffA[2], voffB[2];
#pragma unroll
    for (int i = 0; i < 2; ++i) { int R, C; stage_rc(tid * 16 + i * 8192, R, C); const int Rb = Epi::PERM ? ((R & ~31) + perm32(R & 31)) : R;
        voffA[i] = (unsigned)(R * K + C) * 2u; voffB[i] = (unsigned)(Rb * K + C) * 2u; }
    const size_t kstep = (size_t)(BK * 2);
    const size_t hstep = (size_t)HALF * K * 2;
    const size_t tstep = 2 * hstep;
    const unsigned ldsw = (unsigned)wid * 1024u;
    const int aoff = lds_byte(wr * 64 + fr, fq * 8), boff = lds_byte(wc * 32 + fr, fq * 8);
#define PG8_SA(b, h) (((b) * 2 + (h)) * HTB)
#define PG8_SB(b, h) ((4 + (b) * 2 + (h)) * HTB)
#define PG8_STAGE(bufoff, gbase, voff) do { _Pragma("unroll") for (int _i = 0; _i < 2; ++_i) \
        __builtin_amdgcn_global_load_lds((const unsigned*)((const char*)(gbase) + (voff)[_i]), (PG8_LAS unsigned*)(lds + (bufoff) + ldsw + _i * 8192), 16, 0, 0); } while (0)
#define PG8_LDA(dst, b, h) do { _Pragma("unroll") for (int m = 0; m < 4; ++m) _Pragma("unroll") for (int k = 0; k < 2; ++k) dst[m][k] = *(const PG8_LAS bf16x8*)(lds + PG8_SA(b, h) + aoff + m * 2048 + k * 1024); } while (0)
#define PG8_LDB(dst, b, h) do { _Pragma("unroll") for (int n = 0; n < 2; ++n) _Pragma("unroll") for (int k = 0; k < 2; ++k) dst[n][k] = *(const PG8_LAS bf16x8*)(lds + PG8_SB(b, h) + boff + n * 2048 + k * 1024); } while (0)
#define PG8_MMA(ai, bj, At, Bt) do { __builtin_amdgcn_s_setprio(1); _Pragma("unroll") for (int m = 0; m < 4; ++m) _Pragma("unroll") for (int n = 0; n < 2; ++n) _Pragma("unroll") for (int k = 0; k < 2; ++k) \
        acc[ai][bj][m][n] = __builtin_amdgcn_mfma_f32_16x16x32_bf16(Bt[n][k], At[m][k], acc[ai][bj][m][n], 0, 0, 0); __builtin_amdgcn_s_setprio(0); } while (0)
#define PG8_WAIT_V(n) asm volatile("s_waitcnt vmcnt(" #n ")" ::: "memory")
#define PG8_WAIT_L(n) asm volatile("s_waitcnt lgkmcnt(" #n ")" ::: "memory")
#define PG8_BAR __builtin_amdgcn_s_barrier()
#define PG8_SCHED __builtin_amdgcn_sched_barrier(0)
    Unit cur, nxt; int ui = 0;
    if (!S.next(0, cur)) return;
    f32x4 acc[2][2][4][2];
#pragma unroll
    for (int a = 0; a < 2; ++a)
#pragma unroll
        for (int b = 0; b < 2; ++b)
#pragma unroll
            for (int m = 0; m < 4; ++m)
#pragma unroll
                for (int n = 0; n < 2; ++n) acc[a][b][m][n] = (f32x4){0.f, 0.f, 0.f, 0.f};
    bf16x8 At[4][2], B0[2][2], B1[2][2];
    const char* cA = (const char*)g.A + (size_t)cur.pm * tstep; const char* cB = (const char*)g.Bt + (size_t)cur.pn * tstep;
    S.a_ready(cur);
    if constexpr (SP2) {
        PG8_STAGE(PG8_SB(0, 0), cB, voffB); PG8_STAGE(PG8_SB(0, 1), cB + hstep, voffB); PG8_STAGE(PG8_SA(0, 0), cA, voffA); PG8_STAGE(PG8_SA(0, 1), cA + hstep, voffA);
        if (wr == 1) PG8_BAR;
        PG8_WAIT_V(2); PG8_BAR;
        PG8_STAGE(PG8_SB(1, 0), cB + kstep, voffB); PG8_STAGE(PG8_SA(1, 0), cA + kstep, voffA); PG8_STAGE(PG8_SB(1, 1), cB + hstep + kstep, voffB);
        PG8_WAIT_V(6); PG8_BAR;
    } else {
        PG8_STAGE(PG8_SB(0, 0), cB, voffB); PG8_STAGE(PG8_SA(0, 0), cA, voffA); PG8_STAGE(PG8_SB(0, 1), cB + hstep, voffB); PG8_STAGE(PG8_SA(0, 1), cA + hstep, voffA);
        if (wr == 1) PG8_BAR;
        PG8_WAIT_V(4); PG8_BAR;
        PG8_STAGE(PG8_SB(1, 0), cB + kstep, voffB); PG8_STAGE(PG8_SA(1, 0), cA + kstep, voffA); PG8_STAGE(PG8_SB(1, 1), cB + hstep + kstep, voffB);
        PG8_WAIT_V(6); PG8_BAR;
    }
    for (;;) {
        const bool has_next = S.next(ui + 1, nxt);
        const char* nA = has_next ? (const char*)g.A + (size_t)nxt.pm * tstep : cA; const char* nB = has_next ? (const char*)g.Bt + (size_t)nxt.pn * tstep : cB;
        for (int t = 0; t < nt; t += 2) {
            const bool last = (t == nt - 2);
            const char* a1 = cA + (size_t)(t + 1) * kstep;
            const char* a2 = last ? nA : cA + (size_t)(t + 2) * kstep; const char* b2 = last ? nB : cB + (size_t)(t + 2) * kstep;
            const char* a3 = a2 + kstep; const char* b3 = b2 + kstep;
            if (last && has_next) S.a_ready(nxt);
            if constexpr (SP2) {
            PG8_LDB(B0, 0, 0); PG8_LDB(B1, 0, 1); PG8_SCHED; PG8_LDA(At, 0, 0); PG8_STAGE(PG8_SA(1, 1), a1 + hstep, voffA);
            PG8_WAIT_V(8); PG8_WAIT_L(0); PG8_BAR; PG8_MMA(0, 0, At, B0); PG8_MMA(0, 1, At, B1); PG8_BAR; PG8_SCHED;
            PG8_LDA(At, 0, 1); PG8_STAGE(PG8_SB(0, 0), b2, voffB); PG8_STAGE(PG8_SB(0, 1), b2 + hstep, voffB); PG8_STAGE(PG8_SA(0, 0), a2, voffA);
            PG8_WAIT_V(8); PG8_WAIT_L(0); PG8_BAR; PG8_MMA(1, 0, At, B0); PG8_MMA(1, 1, At, B1); PG8_BAR; PG8_SCHED;
            PG8_LDB(B0, 1, 0); PG8_LDB(B1, 1, 1); PG8_SCHED; PG8_LDA(At, 1, 0); PG8_STAGE(PG8_SA(0, 1), a2 + hstep, voffA);
            PG8_WAIT_V(8); PG8_WAIT_L(0); PG8_BAR; PG8_MMA(0, 0, At, B0); PG8_MMA(0, 1, At, B1); PG8_BAR; PG8_SCHED;
            PG8_LDA(At, 1, 1); PG8_STAGE(PG8_SB(1, 0), b3, voffB); PG8_STAGE(PG8_SB(1, 1), b3 + hstep, voffB); PG8_STAGE(PG8_SA(1, 0), a3, voffA);
            PG8_WAIT_V(8); PG8_WAIT_L(0); PG8_BAR; PG8_MMA(1, 0, At, B0); PG8_MMA(1, 1, At, B1); PG8_BAR; PG8_SCHED;
            } else {
            PG8_LDB(B0, 0, 0); PG8_SCHED; PG8_LDA(At, 0, 0); PG8_STAGE(PG8_SA(1, 1), a1 + hstep, voffA);
            PG8_WAIT_L(8); PG8_BAR; PG8_WAIT_L(0); PG8_MMA(0, 0, At, B0); PG8_BAR; PG8_SCHED;
            PG8_LDB(B1, 0, 1); PG8_STAGE(PG8_SB(0, 0), b2, voffB);
            PG8_BAR; PG8_WAIT_L(0); PG8_MMA(0, 1, At, B1); PG8_BAR;
            PG8_LDA(At, 0, 1); PG8_STAGE(PG8_SA(0, 0), a2, voffA);
            PG8_BAR; PG8_WAIT_L(0); PG8_MMA(1, 0, At, B0); PG8_BAR; PG8_SCHED;
            PG8_STAGE(PG8_SB(0, 1), b2 + hstep, voffB);
            PG8_WAIT_V(6); PG8_BAR; PG8_MMA(1, 1, At, B1); PG8_BAR;
            PG8_LDB(B0, 1, 0); PG8_SCHED; PG8_LDA(At, 1, 0); PG8_STAGE(PG8_SA(0, 1), a2 + hstep, voffA);
            PG8_WAIT_L(8); PG8_BAR; PG8_WAIT_L(0); PG8_MMA(0, 0, At, B0); PG8_BAR; PG8_SCHED;
            PG8_LDB(B1, 1, 1); PG8_STAGE(PG8_SB(1, 0), b3, voffB);
            PG8_BAR; PG8_WAIT_L(0); PG8_MMA(0, 1, At, B1); PG8_BAR;
            PG8_LDA(At, 1, 1); PG8_STAGE(PG8_SA(1, 0), a3, voffA);
            PG8_BAR; PG8_WAIT_L(0); PG8_MMA(1, 0, At, B0); PG8_BAR; PG8_SCHED;
            PG8_STAGE(PG8_SB(1, 1), b3 + hstep, voffB);
            PG8_WAIT_V(6); PG8_BAR; PG8_MMA(1, 1, At, B1); PG8_BAR;
            }
        }
        if constexpr (ALIGN_EPI) { if (wr == 0) PG8_BAR; }
        if constexpr (!Epi::AFTER_DRAIN) { E(acc, cur, wr, wc, fr, fq); S.done(cur); }
        if (!has_next) break;
#pragma unroll
        for (int a = 0; a < 2; ++a)
#pragma unroll
            for (int b = 0; b < 2; ++b)
#pragma unroll
                for (int m = 0; m < 4; ++m)
#pragma unroll
                    for (int n = 0; n < 2; ++n) acc[a][b][m][n] = (f32x4){0.f, 0.f, 0.f, 0.f};
        cur = nxt; cA = nA; cB = nB; ++ui;
        if constexpr (ALIGN_EPI) { if (wr == 1) PG8_BAR; }
    }
    PG8_WAIT_V(0);
    if constexpr (!ALIGN_EPI) { if (wr == 0) PG8_BAR; }
    PG8_BAR;
    if constexpr (Epi::AFTER_DRAIN) { E.fused(acc, cur, wr, wc, fr, fq, lds, wid, lane); S.done(cur); }
#undef PG8_SA
#undef PG8_SB
#undef PG8_STAGE
#undef PG8_LDA
#undef PG8_LDB
#undef PG8_MMA
#undef PG8_WAIT_V
#undef PG8_WAIT_L
#undef PG8_BAR
#undef PG8_SCHED
}
}

using pg8::bf16_t; using pg8::bf16x8; using pg8::f32x4; using pg8::u32x4; using pg8::Unit; using pg8::Gemm;
#define LAS __attribute__((address_space(3)))
#define TIDX() ({ unsigned z__ = 0u; asm volatile("" : "+v"(z__)); wave_s * 64 + (int)__builtin_amdgcn_mbcnt_hi(~0u, __builtin_amdgcn_mbcnt_lo(~0u, z__)); })
#define XB_TMO      128
#define XB_XCNT(j)  (256  + 64 * (j))
#define XB_XSUB(j)  (1280 + 64 * (j))
#define XB_XGEN(j)  (2304 + 64 * (j))
#define XB_TOP      3328
#define XB_TOPGEN   3392
#define XCD_BAR_WORDS 3456
#define XB_SPIN_CAP (1u << 18)

__device__ __forceinline__ unsigned xb_ld(unsigned* p)              { return __hip_atomic_load(p, __ATOMIC_RELAXED, __HIP_MEMORY_SCOPE_AGENT); }
__device__ __forceinline__ unsigned xb_add(unsigned* p, unsigned v) { return __hip_atomic_fetch_add(p, v, __ATOMIC_RELAXED, __HIP_MEMORY_SCOPE_AGENT); }
__device__ __forceinline__ unsigned xb_xcc_id() { return (unsigned)__builtin_amdgcn_s_getreg((3 << 11) | 20) & 0xFu; }
#define XB_SPIN(cond, bar) do { unsigned _sp = 0; while (cond) { __builtin_amdgcn_s_sleep(0); \
    if ((++_sp & 255u) == 0u) { if (xb_ld(&(bar)[XB_TMO])) break; if (_sp > XB_SPIN_CAP) { atomicAdd(&(bar)[XB_TMO], 1u); break; } } } } while (0)

struct XcdBarrier {
    unsigned* bar; unsigned x;
    volatile LAS unsigned* st;
};

__device__ __forceinline__ XcdBarrier xcd_barrier_post(unsigned* bar, volatile LAS unsigned* st, const int wave_s) {
    XcdBarrier b; b.bar = bar; b.x = xb_xcc_id(); b.st = st;
    if (TIDX() == 0) (void)xb_add(&bar[XB_XCNT(b.x)], 1u);
    return b;
}
__device__ __forceinline__ void xcd_barrier_complete(unsigned* bar, unsigned x, unsigned& nloc, unsigned& nx) {
    const unsigned G = gridDim.x * gridDim.y * gridDim.z;
    unsigned sum, cnt, mine, sp = 0u;
    for (;;) {
        sum = 0u; cnt = 0u; mine = 0u;
#pragma unroll
        for (unsigned j = 0; j < 16; ++j) { const unsigned c = xb_ld(&bar[XB_XCNT(j)]); sum += c; cnt += (c > 0u) ? 1u : 0u; mine = (j == x) ? c : mine; }
        if (sum == G) break;
        __builtin_amdgcn_s_sleep(1);
        if ((++sp & 255u) == 0u) { if (xb_ld(&bar[XB_TMO])) break; if (sp > XB_SPIN_CAP) { atomicAdd(&bar[XB_TMO], 1u); break; } }
    }
    nloc = mine > 0u ? mine : 1u; nx = cnt > 0u ? cnt : 1u;
}

__device__ __forceinline__ void xcd_barrier(const XcdBarrier& b, const int wave_s) {
    asm volatile("s_waitcnt vmcnt(0)" ::: "memory");
    __syncthreads();
    if (TIDX() == 0) {
        unsigned* bar = b.bar;
        __builtin_amdgcn_s_waitcnt(0);
        unsigned nloc = b.st[0], nx = b.st[1];
        if (nloc == 0u) { xcd_barrier_complete(bar, b.x, nloc, nx); b.st[0] = nloc; b.st[1] = nx; }
        const unsigned old = xb_add(&bar[XB_XSUB(b.x)], 1u);
        const unsigned gen = old / nloc;
        if (old + 1u == (gen + 1u) * nloc) {
            __builtin_amdgcn_fence(__ATOMIC_RELEASE, "agent");
            asm volatile("s_waitcnt vmcnt(0)" ::: "memory");
            const unsigned og = xb_add(&bar[XB_TOP], 1u);
            const unsigned tg = og / nx;
            if (og + 1u == (tg + 1u) * nx) xb_add(&bar[XB_TOPGEN], 1u);
            else XB_SPIN(xb_ld(&bar[XB_TOPGEN]) == tg, bar);
            __builtin_amdgcn_fence(__ATOMIC_ACQUIRE, "agent");
            xb_add(&bar[XB_XGEN(b.x)], 1u);
            asm volatile("s_waitcnt vmcnt(0)" ::: "memory");
        } else {
            XB_SPIN(xb_ld(&bar[XB_XGEN(b.x)]) == gen, bar);
            __builtin_amdgcn_fence(__ATOMIC_ACQUIRE, "agent");
            asm volatile("s_waitcnt vmcnt(0)" ::: "memory");
        }
    }
    __syncthreads();
}

typedef float f32x16 __attribute__((ext_vector_type(16)));
typedef unsigned u32x2 __attribute__((ext_vector_type(2)));

constexpr int M_TOK = 32768, DM = 1024, SEQ = 2048, DFF = 2816;
constexpr float EPS = 1e-6f, LOG2E = 1.4426950408889634f;
constexpr size_t MiB = 1u << 20;
constexpr size_t OFF_WGU = 0;
constexpr size_t OFF_WDN = 88 * MiB;
constexpr size_t OFF_WGA = 132 * MiB;
constexpr size_t OFF_WGV = 141 * MiB;
constexpr size_t OFF_WGO = 145 * MiB;
constexpr size_t OFF_WDQK = 149 * MiB;
constexpr size_t OFF_WDV = 157 * MiB;
constexpr size_t OFF_WDO = 161 * MiB;
constexpr size_t OFF_XB = 165 * MiB;
constexpr size_t OFF_SSQ = 229 * MiB;
constexpr size_t OFF_SMALL = 230 * MiB;
constexpr int SM_W2 = 0, SM_BG = 32768, SM_GON = 34816, SM_QKG = 35328, SM_LAM = 35584, SM_SUBG = 36096, SM_TOTAL = 36352;
constexpr size_t OFF_CTL = 230 * MiB + 512 * 1024;
constexpr size_t OFF_BIASM = 231 * MiB;
constexpr size_t OFF_BIG = 232 * MiB;
constexpr size_t BIG_ACT = 0;
constexpr size_t BIG_QK = 0;
constexpr size_t BIG_G = 64 * MiB;
constexpr size_t BIG_VT = 128 * MiB;
constexpr size_t BIG_QE = 192 * MiB;
constexpr size_t BIG_KE = 256 * MiB;
constexpr size_t BIG_KDT = 320 * MiB;
constexpr size_t BIG_LR = 384 * MiB;
constexpr size_t BIG_EBE = 388 * MiB;
constexpr size_t BIG_OBB = 390 * MiB;
constexpr size_t WS_END = OFF_BIG + 454 * MiB;
constexpr int LDS_BYTES = 157696;

typedef float f32x2_t __attribute__((ext_vector_type(2))); typedef __bf16 bf16x2_t __attribute__((ext_vector_type(2)));
__device__ __forceinline__ unsigned cvtpk(float lo, float hi) { f32x2_t v = {lo, hi}; bf16x2_t b = __builtin_convertvector(v, bf16x2_t); return __builtin_bit_cast(unsigned, b); }
__device__ __forceinline__ float bf2f(bf16_t v) { return __uint_as_float(((unsigned)v) << 16); }
__device__ __forceinline__ bf16_t f2bf(float f) { return (bf16_t)(cvtpk(f, 0.f) & 0xffffu); }
typedef unsigned long long u64;
constexpr float SSQ_SCALE = 16777216.f;
__device__ __forceinline__ float row_rstd(const u64* ssq, int row) { return rsqrtf((float)ssq[row] * (1.f / (SSQ_SCALE * 1024.f)) + EPS); }
__device__ __forceinline__ float silu_f(float x) { return x * __builtin_amdgcn_rcpf(1.f + __builtin_amdgcn_exp2f(-x * LOG2E)); }
__device__ __forceinline__ int crow(int r, int hi) { return (r & 3) + 8 * (r >> 2) + 4 * hi; }
#define MFMA32(a, b, c) __builtin_amdgcn_mfma_f32_32x32x16_bf16((a), (b), (c), 0, 0, 0)
#define BAR_LDS() do { asm volatile("s_waitcnt lgkmcnt(0)" ::: "memory"); __builtin_amdgcn_s_barrier(); asm volatile("" ::: "memory"); } while (0)

constexpr int RSTD_LDS_OFF = 131072;
static_assert(RSTD_LDS_OFF + 15 * 1024 <= LDS_BYTES - 64, "rstd slots");
__device__ __forceinline__ void stage_rstd(const pg8::StaticOrder& S, const u64* ssq, LAS unsigned char* ldsb, int swapped, const int wave_s) {
    const int tid = TIDX(); Unit u;
    for (int i = tid >> 8; S.next(i, u); i += 2) { const int row = (swapped ? u.pn : u.pm) * 256 + (tid & 255); ((LAS float*)(ldsb + RSTD_LDS_OFF))[i * 256 + (tid & 255)] = row_rstd(ssq, row); }
    asm volatile("s_waitcnt vmcnt(0) lgkmcnt(0)" ::: "memory"); __builtin_amdgcn_s_barrier(); asm volatile("" ::: "memory");
}
#define RSTD_SLOT(kk_, local_) (((const LAS float*)(ldsb + RSTD_LDS_OFF))[(kk_) * 256 + (local_)])
struct EpiGU { static constexpr bool PERM = true, AFTER_DRAIN = false;
    bf16_t* act; LAS unsigned char* ldsb; mutable int kk;
    __device__ __forceinline__ void operator()(const f32x4 (&acc)[2][2][4][2], const Unit& u, int wr, int wc, int fr, int fq) const {
        const int row0 = u.pm * 256 + wr * 64 + fr, col0 = u.pn * 128 + wc * 32 + 8 * fq;
#pragma unroll
        for (int ai = 0; ai < 2; ++ai)
#pragma unroll
            for (int m = 0; m < 4; ++m) { const int row = row0 + ai * 128 + m * 16; const float rs = RSTD_SLOT(kk, wr * 64 + fr + ai * 128 + m * 16);
                const float c1 = -LOG2E * rs, c2 = rs * rs; f32x2_t o2[4];
#pragma unroll
                for (int n = 0; n < 2; ++n)
#pragma unroll
                    for (int jp = 0; jp < 2; ++jp) { const f32x2_t g2 = {acc[ai][0][m][n][2 * jp], acc[ai][0][m][n][2 * jp + 1]}, u2 = {acc[ai][1][m][n][2 * jp], acc[ai][1][m][n][2 * jp + 1]};
                        const f32x2_t mm = g2 * c1; f32x2_t t; t.x = __builtin_amdgcn_exp2f(mm.x); t.y = __builtin_amdgcn_exp2f(mm.y);
                        const f32x2_t dd = t + 1.f; f32x2_t r; r.x = __builtin_amdgcn_rcpf(dd.x); r.y = __builtin_amdgcn_rcpf(dd.y);
                        o2[n * 2 + jp] = (g2 * u2) * (r * c2); }
                u32x4 w; w.x = cvtpk(o2[0].x, o2[0].y); w.y = cvtpk(o2[1].x, o2[1].y); w.z = cvtpk(o2[2].x, o2[2].y); w.w = cvtpk(o2[3].x, o2[3].y);
                *(u32x4*)(act + (size_t)row * DFF + col0) = w; }
        ++kk;
    }
};
struct EpiRes { static constexpr bool PERM = true, AFTER_DRAIN = false;
    float* fout; bf16_t* xb; u64* ssq; u64* ssq_zero; float alpha; int dry;
    __device__ __forceinline__ void operator()(const f32x4 (&acc)[2][2][4][2], const Unit& u, int wr, int wc, int fr, int fq) const {
        const int row0 = u.pm * 256 + wr * 64 + fr, col0 = u.pn * 256 + wc * 32 + 8 * fq;
#pragma unroll
        for (int ai = 0; ai < 2; ++ai)
#pragma unroll
            for (int m = 0; m < 4; ++m) { const int row = row0 + ai * 128 + m * 16; float ss = 0.f;
#pragma unroll
                for (int bj = 0; bj < 2; ++bj) { const size_t off = (size_t)row * DM + col0 + bj * 128;
                    const u32x4 xo = *(const u32x4*)(xb + off);
                    f32x4 x0, x1;
                    x0[0] = __uint_as_float(xo.x << 16); x0[1] = __uint_as_float(xo.x & 0xffff0000u); x0[2] = __uint_as_float(xo.y << 16); x0[3] = __uint_as_float(xo.y & 0xffff0000u);
                    x1[0] = __uint_as_float(xo.z << 16); x1[1] = __uint_as_float(xo.z & 0xffff0000u); x1[2] = __uint_as_float(xo.w << 16); x1[3] = __uint_as_float(xo.w & 0xffff0000u);
                    x0 = x0 + acc[ai][bj][m][0] * alpha; x1 = x1 + acc[ai][bj][m][1] * alpha;
                    u32x4 w; w.x = cvtpk(x0[0], x0[1]); w.y = cvtpk(x0[2], x0[3]); w.z = cvtpk(x1[0], x1[1]); w.w = cvtpk(x1[2], x1[3]);
                    if (fout) { *(f32x4*)(fout + off) = x0; *(f32x4*)(fout + off + 4) = x1; } else *(u32x4*)(xb + off) = w;
                    ss += ((x0[0] * x0[0] + x0[1] * x0[1]) + (x0[2] * x0[2] + x0[3] * x0[3])) + ((x1[0] * x1[0] + x1[1] * x1[1]) + (x1[2] * x1[2] + x1[3] * x1[3])); }
                ss += __shfl_xor(ss, 16); ss += __shfl_xor(ss, 32);
                if (fq == 0 && !dry && !fout) { atomicAdd(ssq + row, (u64)(ss * SSQ_SCALE)); if (u.pn == 0 && wc == 0) ssq_zero[row] = 0ull; } }
    }
};
struct EpiGlaA { static constexpr bool PERM = true, AFTER_DRAIN = false;
    bf16_t* qk; bf16_t* g; float* lr; LAS unsigned char* ldsb; mutable int kk;
    __device__ __forceinline__ void operator()(const f32x4 (&acc)[2][2][4][2], const Unit& u, int wr, int wc, int fr, int fq) const {
        const int row0 = u.pm * 256 + wr * 64 + fr;
        if (u.pn < 8) {
            bf16_t* base = (u.pn < 4) ? qk : g; const int col0 = (u.pn & 3) * 256 + wc * 32 + 8 * fq;
#pragma unroll
            for (int ai = 0; ai < 2; ++ai)
#pragma unroll
                for (int m = 0; m < 4; ++m) { const int row = row0 + ai * 128 + m * 16; const float rs = RSTD_SLOT(kk, wr * 64 + fr + ai * 128 + m * 16);
#pragma unroll
                    for (int bj = 0; bj < 2; ++bj) { const f32x4 v0 = acc[ai][bj][m][0] * rs, v1 = acc[ai][bj][m][1] * rs;
                        u32x4 w; w.x = cvtpk(v0[0], v0[1]); w.y = cvtpk(v0[2], v0[3]); w.z = cvtpk(v1[0], v1[1]); w.w = cvtpk(v1[2], v1[3]);
                        *(u32x4*)(base + (size_t)row * DM + col0 + bj * 128) = w; } }
        } else if (wc == 0) {
#pragma unroll
            for (int ai = 0; ai < 2; ++ai)
#pragma unroll
                for (int m = 0; m < 4; ++m) { const int row = row0 + ai * 128 + m * 16; const float rs = RSTD_SLOT(kk, wr * 64 + fr + ai * 128 + m * 16);
                    *(f32x4*)(lr + (size_t)row * 32 + 8 * fq) = acc[ai][0][m][0] * rs; *(f32x4*)(lr + (size_t)row * 32 + 8 * fq + 4) = acc[ai][0][m][1] * rs; }
        }
        ++kk;
    }
};
template <int DIFF> struct EpiVt { static constexpr bool PERM = true, AFTER_DRAIN = false;
    bf16_t* vt; LAS unsigned char* ldsb; mutable int kk;
    __device__ __forceinline__ void operator()(const f32x4 (&acc)[2][2][4][2], const Unit& u, int wr, int wc, int fr, int fq) const {
#pragma unroll
        for (int bj = 0; bj < 2; ++bj) { const int tk0 = u.pn * 256 + bj * 128 + wc * 32 + 8 * fq; float rs[8];
#pragma unroll
            for (int e = 0; e < 8; ++e) rs[e] = RSTD_SLOT(kk, bj * 128 + wc * 32 + 8 * fq + e);
            const int b = tk0 >> 11, t = tk0 & 2047;
#pragma unroll
            for (int ai = 0; ai < 2; ++ai)
#pragma unroll
                for (int m = 0; m < 4; ++m) { const int vrow = u.pm * 256 + ai * 128 + wr * 64 + m * 16 + fr;
                    const f32x4 a0 = acc[ai][bj][m][0], a1 = acc[ai][bj][m][1];
                    u32x4 w; w.x = cvtpk(a0[0] * rs[0], a0[1] * rs[1]); w.y = cvtpk(a0[2] * rs[2], a0[3] * rs[3]);
                    w.z = cvtpk(a1[0] * rs[4], a1[1] * rs[5]); w.w = cvtpk(a1[2] * rs[6], a1[3] * rs[7]);
                    size_t addr;
                    if (DIFF) { const int h = vrow >> 7, dv = vrow & 127; addr = ((size_t)(b * 8 + h) * 128 + dv) * 2048 + t; }
                    else { const int h = vrow >> 8, dv = vrow & 255, c = t >> 6, r = t & 63; addr = (((size_t)(b * 32 + c) * 4 + h) * 256 + dv) * 64 + r; }
                    *(u32x4*)(vt + addr) = w; } }
        ++kk;
    }
};
struct EpiQkDiff { static constexpr bool PERM = true, AFTER_DRAIN = false;
    bf16_t* qk; LAS unsigned char* ldsb; const float* gq; const float* gk; mutable int kk;
    __device__ __forceinline__ void operator()(const f32x4 (&acc)[2][2][4][2], const Unit& u, int wr, int wc, int fr, int fq) const {
        const int row0 = u.pm * 256 + wr * 64 + fr; const bool isq = u.pn < 4; const float* gp = isq ? gq : gk; const float sc = isq ? 0.125f * LOG2E : 1.f;
        f32x4 gv[2][2];
#pragma unroll
        for (int bj = 0; bj < 2; ++bj)
#pragma unroll
            for (int n = 0; n < 2; ++n) gv[bj][n] = *(const f32x4*)(gp + 32 * bj + 8 * fq + 4 * n) * sc;
        const int col0 = u.pn * 256 + wc * 64 + 8 * fq;
#pragma unroll
        for (int ai = 0; ai < 2; ++ai)
#pragma unroll
            for (int m = 0; m < 4; ++m) { const int row = row0 + ai * 128 + m * 16; const float rs = RSTD_SLOT(kk, wr * 64 + fr + ai * 128 + m * 16);
                f32x4 v[2][2]; float ss = 0.f;
#pragma unroll
                for (int bj = 0; bj < 2; ++bj)
#pragma unroll
                    for (int n = 0; n < 2; ++n) { v[bj][n] = acc[ai][bj][m][n] * rs; ss += (v[bj][n][0] * v[bj][n][0] + v[bj][n][1] * v[bj][n][1]) + (v[bj][n][2] * v[bj][n][2] + v[bj][n][3] * v[bj][n][3]); }
                ss += __shfl_xor(ss, 16); ss += __shfl_xor(ss, 32);
                const float r2 = rsqrtf(ss * (1.f / 64.f) + EPS);
#pragma unroll
                for (int bj = 0; bj < 2; ++bj) { const f32x4 v0 = v[bj][0] * gv[bj][0] * r2, v1 = v[bj][1] * gv[bj][1] * r2;
                    u32x4 w; w.x = cvtpk(v0[0], v0[1]); w.y = cvtpk(v0[2], v0[3]); w.z = cvtpk(v1[0], v1[1]); w.w = cvtpk(v1[2], v1[3]);
                    *(u32x4*)(qk + (size_t)row * 2048 + col0 + bj * 32) = w; } }
        ++kk;
    }
};

__device__ __forceinline__ unsigned pk2(float lo, float hi) { return cvtpk(lo, hi); }
__device__ __forceinline__ void transpose_item(const float* W, int ldw, int src, int k0, const float* gvec, float scale, bf16_t* dst, int K, LAS float* scr, int lane) {
    const int kr = lane >> 3, n4 = (lane & 7) * 4;
    f32x4 v[8];
#pragma unroll
    for (int i = 0; i < 8; ++i) { v[i] = (f32x4){0.f, 0.f, 0.f, 0.f}; if (src >= 0) v[i] = *(const f32x4*)(W + (size_t)(k0 + 8 * i + kr) * ldw + src + n4); }
#pragma unroll
    for (int i = 0; i < 8; ++i) { const int kk = 8 * i + kr; float gs = scale; if (gvec) gs *= gvec[k0 + kk];
        LAS float* sp = scr + kk * 33 + n4; sp[0] = v[i][0] * gs; sp[1] = v[i][1] * gs; sp[2] = v[i][2] * gs; sp[3] = v[i][3] * gs; }
    asm volatile("s_waitcnt lgkmcnt(0)" ::: "memory");
    const int c = lane & 7;
#pragma unroll
    for (int j = 0; j < 4; ++j) { const int n = (lane >> 3) + 8 * j; const LAS float* s = scr + (8 * c) * 33 + n;
        u32x4 o; o.x = pk2(s[0 * 33], s[1 * 33]); o.y = pk2(s[2 * 33], s[3 * 33]); o.z = pk2(s[4 * 33], s[5 * 33]); o.w = pk2(s[6 * 33], s[7 * 33]);
        *(u32x4*)(dst + (size_t)n * K + k0 + 8 * c) = o; }
    asm volatile("s_waitcnt lgkmcnt(0)" ::: "memory");
}
__device__ __forceinline__ void weight_job(const float* W, int ldw, int K, int nblk, bf16_t* dst, const float* gvec, int type, int coff, LAS float* scr, int gw, int NGW, int lane) {
    const int nkb = K / 64, items = nkb * nblk;
    for (int it = gw; it < items; it += NGW) { const int kb = it / nblk, nb = it % nblk; int src = coff + 32 * nb; float scale = 1.f;
        if (type == 1) { const int pn = nb >> 3, rho = (nb & 7) * 32; src = (rho >> 7) * DFF + 128 * pn + (rho & 127); }
        else if (type == 2) { if (nb < 16) { src = 32 * nb; scale = 0.08838834764831845f; } else if (nb < 32) src = 32 * nb; else if (nb < 64) src = 2048 + 32 * (nb - 32); else if (nb == 64) src = 3072; else src = -1; }
        else if (type == 3) { const int pn = nb >> 3, rho = (nb & 7) * 32, bj = rho >> 7, wc = (rho & 127) >> 5; src = 256 * pn + 64 * wc + 32 * bj; }
        transpose_item(W, ldw, src, kb * 64, gvec, scale, dst + (size_t)nb * 32 * K, K, scr, lane); }
}
__device__ __forceinline__ float wave_sum(float v) {
#pragma unroll
    for (int o = 1; o < 64; o <<= 1) v += __shfl_xor(v, o);
    return v;
}
__device__ __forceinline__ int t5_bucket(int rel) {
    const int n = rel < 0 ? -rel : rel; int bk;
    if (n < 8) bk = n; else bk = n < 12 ? 8 : n < 16 ? 9 : n < 23 ? 10 : n < 32 ? 11 : n < 46 ? 12 : n < 64 ? 13 : n < 91 ? 14 : 15;
    return bk + (rel > 0 ? 16 : 0);
}

__device__ __forceinline__ void gla_prep(LAS unsigned char* lds, const bf16_t* QK, const float* LR, const float* w2, const float* bg, bf16_t* QE, bf16_t* KE, bf16_t* KDT, float* EBE, int vcu, int G, const int wave_s) {
    constexpr int L_Q = 8192, L_K = L_Q + 17408, L_QE = L_K + 17408, L_KE = L_QE + 17408, PQ = 272;
    LAS float* lrs = (LAS float*)lds; LAS float* parts = lrs + 1024;
    int tid_ = TIDX(); asm volatile("" : "+v"(tid_)); const int tid = tid_, d = tid & 127, part = tid >> 7;
    for (int e = vcu; e < 4096; e += G) { const int h = e & 3, c = (e >> 2) & 31, b = (e >> 7) & 15, dir = e >> 11;
        BAR_LDS();
#pragma unroll
        for (int i = 0; i < 2; ++i) { const int idx = tid + 512 * i, r = idx >> 4, k = idx & 15; const int pos = dir ? 2047 - (64 * c + r) : 64 * c + r;
            lrs[idx] = LR[(size_t)(b * 2048 + pos) * 32 + dir * 16 + k];
            const size_t R = (size_t)(b * 2048 + pos) * DM + h * 128 + k * 8;
            *(LAS u32x4*)(lds + L_Q + r * PQ + k * 16) = *(const u32x4*)(QK + R); *(LAS u32x4*)(lds + L_K + r * PQ + k * 16) = *(const u32x4*)(QK + R + 512); }
        float w2c[16];
#pragma unroll
        for (int k = 0; k < 16; ++k) w2c[k] = w2[(dir * 16 + k) * 512 + h * 128 + d];
        const float bias = bg[dir * 512 + h * 128 + d];
        BAR_LDS();
        float pre[16]; float run = 0.f;
#pragma unroll
        for (int i = 0; i < 16; ++i) { const int r = part * 16 + i; float z = bias;
#pragma unroll
            for (int k = 0; k < 16; ++k) z += lrs[r * 16 + k] * w2c[k];
            const float la = (fminf(z, 0.f) - __logf(1.f + __expf(-fabsf(z)))) * (1.f / 16.f);
            run += la; pre[i] = run; }
        parts[part * 128 + d] = run;
        BAR_LDS();
        float off = 0.f, bend = 0.f;
#pragma unroll
        for (int p = 0; p < 4; ++p) { const float v = parts[p * 128 + d]; bend += v; if (p < part) off += v; }
        float kd[16];
        const size_t eb = (size_t)e * 8192;
#pragma unroll
        for (int i = 0; i < 16; ++i) { const int r = part * 16 + i; const float bi = off + pre[i];
            const float q = bf2f(*(const LAS bf16_t*)(lds + L_Q + r * PQ + d * 2)), k = bf2f(*(const LAS bf16_t*)(lds + L_K + r * PQ + d * 2));
            *(LAS bf16_t*)(lds + L_QE + r * PQ + d * 2) = f2bf(q * __expf(bi)); *(LAS bf16_t*)(lds + L_KE + r * PQ + d * 2) = f2bf(k * __expf(-bi)); kd[i] = k * __expf(bend - bi); }
        u32x4 w0, w1;
        if (dir == 0) { w0.x = pk2(kd[0], kd[1]); w0.y = pk2(kd[2], kd[3]); w0.z = pk2(kd[4], kd[5]); w0.w = pk2(kd[6], kd[7]);
                        w1.x = pk2(kd[8], kd[9]); w1.y = pk2(kd[10], kd[11]); w1.z = pk2(kd[12], kd[13]); w1.w = pk2(kd[14], kd[15]);
            *(u32x4*)(KDT + eb + d * 64 + part * 16) = w0; *(u32x4*)(KDT + eb + d * 64 + part * 16 + 8) = w1; }
        else { w0.x = pk2(kd[15], kd[14]); w0.y = pk2(kd[13], kd[12]); w0.z = pk2(kd[11], kd[10]); w0.w = pk2(kd[9], kd[8]);
               w1.x = pk2(kd[7], kd[6]); w1.y = pk2(kd[5], kd[4]); w1.z = pk2(kd[3], kd[2]); w1.w = pk2(kd[1], kd[0]);
            *(u32x4*)(KDT + eb + d * 64 + 48 - part * 16) = w0; *(u32x4*)(KDT + eb + d * 64 + 48 - part * 16 + 8) = w1; }
        if (part == 0) EBE[(size_t)e * 128 + d] = __expf(bend);
        BAR_LDS();
#pragma unroll
        for (int i = 0; i < 2; ++i) { const int idx = tid + 512 * i, r = idx >> 4, k = idx & 15;
            *(u32x4*)(QE + eb + r * 128 + k * 8) = *(const LAS u32x4*)(lds + L_QE + r * PQ + k * 16); *(u32x4*)(KE + eb + r * 128 + k * 8) = *(const LAS u32x4*)(lds + L_KE + r * PQ + k * 16); }
    }
}

__device__ __forceinline__ void gla_scan(LAS unsigned char* lds, const bf16_t* QE, const bf16_t* KE, const bf16_t* KDT, const float* EBE, const bf16_t* VT, bf16_t* OBF, bf16_t* OBB, int vcu, int G, const int wave_s) {
    constexpr int PQ = 272, PT = 144;
    constexpr int L_QE = 0, L_KE = 17408, L_KDT = 34816, L_VT = 53248, L_ST = 71680, L_P = 106496, L_EB = 115712, L_OS = 116224;
    int tid_ = TIDX(); asm volatile("" : "+v"(tid_)); const int tid = tid_, lane = tid & 63, w = __builtin_amdgcn_readfirstlane(tid >> 6), r32 = lane & 31, hi = lane >> 5;
    for (int item = vcu; item < 256; item += G) { const int dvh = item & 1, dir = (item >> 1) & 1, h = (item >> 2) & 3, b = item >> 4;
        BAR_LDS();
        for (int i = tid; i < 34816 / 16; i += 512) ((LAS u32x4*)(lds + L_ST))[i] = (u32x4){0u, 0u, 0u, 0u};
        f32x16 S0, S1;
#pragma unroll
        for (int r = 0; r < 16; ++r) { S0[r] = 0.f; S1[r] = 0.f; }
        bf16_t* OB = dir ? OBB : OBF;
        u32x4 rq[2], rk[2], rd[2], rv[2]; f32x4 re = (f32x4){0.f, 0.f, 0.f, 0.f};
#define GS_LOAD(cc) do { const size_t ei_ = ((size_t)((dir * 16 + b) * 32 + (cc)) * 4 + h); const size_t e_ = ei_ * 8192; const int cf_ = dir ? 31 - (cc) : (cc); \
            const size_t v_ = (((size_t)(b * 32 + cf_) * 4 + h) * 256 + dvh * 128) * 64; \
            _Pragma("unroll") for (int i_ = 0; i_ < 2; ++i_) { const int q_ = tid + 512 * i_; rq[i_] = *(const u32x4*)(QE + e_ + q_ * 8); rk[i_] = *(const u32x4*)(KE + e_ + q_ * 8); \
                rd[i_] = *(const u32x4*)(KDT + e_ + q_ * 8); rv[i_] = *(const u32x4*)(VT + v_ + q_ * 8); } \
            if (tid < 32) re = *(const f32x4*)(EBE + ei_ * 128 + tid * 4); } while (0)
#define CHAIN(acc_, ap_, bp_, NK) do { bf16x8 fa_[NK], fb_[NK]; \
            _Pragma("unroll") for (int ks_ = 0; ks_ < (NK); ++ks_) { fa_[ks_] = *(const LAS bf16x8*)((ap_) + ks_ * 32); fb_[ks_] = *(const LAS bf16x8*)((bp_) + ks_ * 32); } \
            __builtin_amdgcn_sched_barrier(0); \
            _Pragma("unroll") for (int ks_ = 0; ks_ < (NK); ++ks_) acc_ = MFMA32(fa_[ks_], fb_[ks_], acc_); \
            __builtin_amdgcn_sched_barrier(0); } while (0)
        GS_LOAD(0);
        for (int c = 0; c < 32; ++c) {
#pragma unroll
            for (int i = 0; i < 2; ++i) { const int q = tid + 512 * i;
                *(LAS u32x4*)(lds + L_QE + (q >> 4) * PQ + (q & 15) * 16) = rq[i]; *(LAS u32x4*)(lds + L_KE + (q >> 4) * PQ + (q & 15) * 16) = rk[i];
                *(LAS u32x4*)(lds + L_KDT + (q >> 3) * PT + (q & 7) * 16) = rd[i]; *(LAS u32x4*)(lds + L_VT + (q >> 3) * PT + (q & 7) * 16) = rv[i]; }
            if (tid < 32) *(LAS f32x4*)(lds + L_EB + tid * 16) = re;
            BAR_LDS();
            if (c + 1 < 32) GS_LOAD(c + 1);
            if (w < 4) { const int mt = w & 1, nt = w >> 1; f32x16 p;
#pragma unroll
                for (int r = 0; r < 16; ++r) p[r] = 0.f;
                if (!(mt == 1 && nt == 0)) { const LAS unsigned char* ap = lds + L_KE + (mt * 32 + r32) * PQ + hi * 16; const LAS unsigned char* bp = lds + L_QE + (nt * 32 + r32) * PQ + hi * 16;
                    CHAIN(p, ap, bp, 8); }
                const int i = nt * 32 + r32;
#pragma unroll
                for (int g = 0; g < 4; ++g) { const int j0 = mt * 32 + 8 * g + 4 * hi; float v[4];
#pragma unroll
                    for (int e2 = 0; e2 < 4; ++e2) { const int j = j0 + e2; const bool keep = dir ? (j < i) : (j <= i); v[e2] = keep ? p[4 * g + e2] : 0.f; }
                    u32x2 wv; int colp;
                    if (dir == 0) { wv.x = pk2(v[0], v[1]); wv.y = pk2(v[2], v[3]); colp = j0; } else { wv.x = pk2(v[3], v[2]); wv.y = pk2(v[1], v[0]); colp = 60 - j0; }
                    *(LAS u32x2*)(lds + L_P + i * PT + colp * 2) = wv; } }
            const int mtO = w & 1, ntO = w >> 1; f32x16 o;
#pragma unroll
            for (int r = 0; r < 16; ++r) o[r] = 0.f;
            { const LAS unsigned char* ap = lds + L_QE + (mtO * 32 + r32) * PQ + hi * 16; const LAS unsigned char* bp = lds + L_ST + (ntO * 32 + r32) * PQ + hi * 16;
              CHAIN(o, ap, bp, 8); }
            const int dkb = w & 3, dvb = (w >> 2) * 2;
            { const LAS unsigned char* ap = lds + L_KDT + (dkb * 32 + r32) * PT + hi * 16; const LAS unsigned char* bp0 = lds + L_VT + (dvb * 32 + r32) * PT + hi * 16; const LAS unsigned char* bp1 = bp0 + 32 * PT;
              bf16x8 fa[4], fb0[4], fb1[4];
#pragma unroll
              for (int ks = 0; ks < 4; ++ks) { fa[ks] = *(const LAS bf16x8*)(ap + ks * 32); fb0[ks] = *(const LAS bf16x8*)(bp0 + ks * 32); fb1[ks] = *(const LAS bf16x8*)(bp1 + ks * 32); }
              const LAS float* ebp = (const LAS float*)(lds + L_EB) + dkb * 32 + 4 * hi;
#pragma unroll
              for (int g = 0; g < 4; ++g) { const f32x4 e4 = *(const LAS f32x4*)(ebp + 8 * g);
#pragma unroll
                  for (int e2 = 0; e2 < 4; ++e2) { S0[4 * g + e2] *= e4[e2]; S1[4 * g + e2] *= e4[e2]; } }
              __builtin_amdgcn_sched_barrier(0);
#pragma unroll
              for (int ks = 0; ks < 4; ++ks) { S0 = MFMA32(fa[ks], fb0[ks], S0); S1 = MFMA32(fa[ks], fb1[ks], S1); }
              __builtin_amdgcn_sched_barrier(0); }
            BAR_LDS();
            { const LAS unsigned char* ap = lds + L_P + (mtO * 32 + r32) * PT + hi * 16; const LAS unsigned char* bp = lds + L_VT + (ntO * 32 + r32) * PT + hi * 16;
              CHAIN(o, ap, bp, 4);
#pragma unroll
              for (int r = 0; r < 16; ++r) *(LAS bf16_t*)(lds + L_OS + (mtO * 32 + crow(r, hi)) * PQ + (ntO * 32 + r32) * 2) = f2bf(o[r]); }
#pragma unroll
            for (int t = 0; t < 2; ++t) { const int dv = (dvb + t) * 32 + r32;
#pragma unroll
                for (int g = 0; g < 4; ++g) { const int dk0 = dkb * 32 + 8 * g + 4 * hi; u32x2 wv;
                    if (t == 0) { wv.x = pk2(S0[4 * g], S0[4 * g + 1]); wv.y = pk2(S0[4 * g + 2], S0[4 * g + 3]); } else { wv.x = pk2(S1[4 * g], S1[4 * g + 1]); wv.y = pk2(S1[4 * g + 2], S1[4 * g + 3]); }
                    *(LAS u32x2*)(lds + L_ST + dv * PQ + dk0 * 2) = wv; } }
            BAR_LDS();
#pragma unroll
            for (int i = 0; i < 2; ++i) { const int q = tid + 512 * i, row = q >> 4, ch = q & 15; const int pos = dir ? 2047 - (c * 64 + row) : c * 64 + row;
                *(u32x4*)(OB + (size_t)(b * 2048 + pos) * DM + h * 256 + dvh * 128 + ch * 8) = *(const LAS u32x4*)(lds + L_OS + row * PQ + ch * 16); }
        }
#undef CHAIN
#undef GS_LOAD
    }
}

__device__ __forceinline__ void gla_combine(const bf16_t* OBF, const bf16_t* OBB, const bf16_t* GT, const float* gon, bf16_t* AO, int vcu, int G, const int wave_s) {
    int tid_ = TIDX(); asm volatile("" : "+v"(tid_)); const int lane = tid_ & 63, gw = vcu * 8 + __builtin_amdgcn_readfirstlane(tid_ >> 6), NGW = G * 8;
    const int dv0 = (lane & 15) * 16;
    for (int row = gw; row < M_TOK; row += NGW) { const size_t off = (size_t)row * DM + lane * 16;
        u32x4 a[2], bb[2], gg[2];
#pragma unroll
        for (int i = 0; i < 2; ++i) { a[i] = *(const u32x4*)(OBF + off + 8 * i); bb[i] = *(const u32x4*)(OBB + off + 8 * i); gg[i] = *(const u32x4*)(GT + off + 8 * i); }
        float o[16], gt[16]; float ss = 0.f;
#pragma unroll
        for (int i = 0; i < 2; ++i)
#pragma unroll
            for (int k = 0; k < 4; ++k) { const unsigned ua = a[i][k], ub = bb[i][k], ug = gg[i][k];
                const float lo = __uint_as_float(ua << 16) + __uint_as_float(ub << 16), hi2 = __uint_as_float(ua & 0xffff0000u) + __uint_as_float(ub & 0xffff0000u);
                o[i * 8 + 2 * k] = lo; o[i * 8 + 2 * k + 1] = hi2; ss += lo * lo + hi2 * hi2;
                gt[i * 8 + 2 * k] = __uint_as_float(ug << 16); gt[i * 8 + 2 * k + 1] = __uint_as_float(ug & 0xffff0000u); }
        ss += __shfl_xor(ss, 1); ss += __shfl_xor(ss, 2); ss += __shfl_xor(ss, 4); ss += __shfl_xor(ss, 8);
        const float rs = rsqrtf(ss * (1.f / 256.f) + EPS);
        u32x4 wv[2];
#pragma unroll
        for (int i = 0; i < 2; ++i)
#pragma unroll
            for (int k = 0; k < 4; ++k) { const int j = i * 8 + 2 * k; const float y0 = o[j] * rs * gon[dv0 + j] * silu_f(gt[j]), y1 = o[j + 1] * rs * gon[dv0 + j + 1] * silu_f(gt[j + 1]); wv[i][k] = pk2(y0, y1); }
        *(u32x4*)(AO + off) = wv[0]; *(u32x4*)(AO + off + 8) = wv[1];
    }
}

__device__ __forceinline__ void attn_phase(LAS unsigned char* lds, const bf16_t* QK2, const bf16_t* VTd, bf16_t* AO, const float* biasm, float lam, const float* subg, float oml, int vcu, int G, const int wave_s) {
    constexpr int PK = 272, PV = 272  , KST = 34816  , STG = 2 * KST  , L_BT = 2 * STG, L_LS = L_BT + 16384;
    static_assert(L_LS + 1024 <= LDS_BYTES - 64, "attention LDS map");
    LAS float* bt = (LAS float*)(lds + L_BT); LAS float* ls = (LAS float*)(lds + L_LS);
#define SCHED_FENCE() __builtin_amdgcn_sched_barrier(0)
    int h_loaded = -1;
#define AT_LOADB(kb_, vb_, kt, RK, RV) do { _Pragma("unroll") for (int i_ = 0; i_ < 2; ++i_) { const int q_ = tid + 512 * i_; \
            RK[i_] = *(const u32x4*)((kb_) + (unsigned)(((kt) * 64 + (q_ >> 4)) * 2048 + (q_ & 15) * 8)); RV[i_] = *(const u32x4*)((vb_) + (unsigned)((q_ >> 3) * 2048 + (kt) * 64 + (q_ & 7) * 8)); } } while (0)
#define Q_LOAD(b_, h_, q0_) do { _Pragma("unroll") for (int ks = 0; ks < 4; ++ks) qv[ks] = *(const bf16x8*)(QK2 + (size_t)((b_) * 2048 + (q0_) + r32) * 2048 + (h_) * 128 + st * 64 + ks * 16 + hi * 8); } while (0)
    u32x4 rkA[2], rvA[2]; bf16x8 qv[4];
    if (vcu < 2048) { int tid_ = TIDX(); asm volatile("" : "+v"(tid_)); const int tid = tid_, lane = tid & 63, w = __builtin_amdgcn_readfirstlane(tid >> 6), r32 = lane & 31, hi = lane >> 5, st = w >> 2, wq = w & 3;
        const int bh = vcu >> 4, qb = vcu & 15, b = bh >> 3, h = bh & 7;
        AT_LOADB(QK2 + (size_t)(b * 2048) * 2048 + 1024 + h * 128, VTd + (size_t)(b * 8 + h) * 128 * 2048, 0, rkA, rvA); Q_LOAD(b, h, qb * 128 + wq * 32); }
    for (int u = vcu; u < 2048; u += G) { const int bh = u >> 4, qb = u & 15, b = bh >> 3, h = bh & 7;
        int tid_ = TIDX(); asm volatile("" : "+v"(tid_));
        const int tid = tid_, lane = tid & 63, w = __builtin_amdgcn_readfirstlane(tid >> 6), r32 = lane & 31, hi = lane >> 5;
        const int st = w >> 2, wq = w & 3;
        const bool has_next = (u + G) < 2048; const int un = u + G, bhn = un >> 4, bn = bhn >> 3, hn = bhn & 7, q0n = (un & 15) * 128 + wq * 32;
        const bf16_t* kbase_n = QK2 + (size_t)(bn * 2048) * 2048 + 1024 + hn * 128;
        const bf16_t* vbase_n = VTd + (size_t)(bn * 8 + hn) * 128 * 2048;
        BAR_LDS();
        if (h != h_loaded) {
#pragma unroll
            for (int i = 0; i < 8; ++i) bt[tid + 512 * i] = biasm[h * 4096 + tid + 512 * i];
            h_loaded = h; }
        const int q0 = qb * 128 + wq * 32;
        const float cpos = __uint_as_float(__builtin_amdgcn_readfirstlane(__float_as_uint(biasm[h * 4096 + 4094]))), cneg = __uint_as_float(__builtin_amdgcn_readfirstlane(__float_as_uint(biasm[h * 4096])));
        f32x16 o[4];
#pragma unroll
        for (int nt = 0; nt < 4; ++nt)
#pragma unroll
            for (int r = 0; r < 16; ++r) o[nt][r] = 0.f;
        float lsum = 0.f;
        const bf16_t* kbase = QK2 + (size_t)(b * 2048) * 2048 + 1024 + h * 128;
        const bf16_t* vbase = VTd + (size_t)(b * 8 + h) * 128 * 2048;
#define AT_LOAD(kt, RK, RV) AT_LOADB(kbase, vbase, kt, RK, RV)
#define VLOAD(dst, vp_, nt_) do { _Pragma("unroll") for (int s4_ = 0; s4_ < 4; ++s4_) { const u32x2 lo_ = *(const LAS u32x2*)((vp_) + (nt_) * 32 * PV + s4_ * 32), h8_ = *(const LAS u32x2*)((vp_) + (nt_) * 32 * PV + s4_ * 32 + 16); \
            dst[s4_] = (u32x4){lo_.x, lo_.y, h8_.x, h8_.y}; } } while (0)
#define ST_MFMA(kt_, sk_) \
        const int kv0 = (kt_) * 64; const bool farp = (kv0 - (q0 + 31)) >= 91, farn = (q0 - (kv0 + 63)) >= 91; \
        const float cin = farp ? cpos : (farn ? cneg : 0.f); \
        f32x16 p0, p1; \
        _Pragma("unroll") for (int r = 0; r < 16; ++r) { p0[r] = cin; p1[r] = cin; } \
        { const LAS unsigned char* kp = lds + (sk_) + r32 * PK + st * 128 + hi * 16; \
          bf16x8 kf0[4]; \
          _Pragma("unroll") for (int ks = 0; ks < 4; ++ks) kf0[ks] = *(const LAS bf16x8*)(kp + ks * 32); \
          SCHED_FENCE(); \
          _Pragma("unroll") for (int ks = 0; ks < 4; ++ks) kf1[ks] = *(const LAS bf16x8*)(kp + 32 * PK + ks * 32);     \
          _Pragma("unroll") for (int ks = 0; ks < 4; ++ks) p0 = MFMA32(kf0[ks], qv[ks], p0); } \
        SCHED_FENCE();
#define ST_SOFTMAX() \
        if (!(farp || farn)) { const int ib = kv0 + 4 * hi - (q0 + r32) + 2047; \
            _Pragma("unroll") for (int r = 0; r < 16; ++r) { const int idx = ib + (r & 3) + 8 * (r >> 2); p0[r] += bt[idx]; } \
            SCHED_FENCE(); \
            _Pragma("unroll") for (int r = 0; r < 16; ++r) { const int idx = ib + (r & 3) + 8 * (r >> 2); p1[r] += bt[idx + 32]; } } \
        _Pragma("unroll") for (int r = 0; r < 16; ++r) { p0[r] = __builtin_amdgcn_exp2f(p0[r]); p1[r] = __builtin_amdgcn_exp2f(p1[r]); lsum += p0[r] + p1[r]; } \
        _Pragma("unroll") for (int k = 0; k < 4; ++k) { pa[0][k] = pk2(p0[2 * k], p0[2 * k + 1]); pa[1][k] = pk2(p0[8 + 2 * k], p0[8 + 2 * k + 1]); pa[2][k] = pk2(p1[2 * k], p1[2 * k + 1]); pa[3][k] = pk2(p1[8 + 2 * k], p1[8 + 2 * k + 1]); } \
        SCHED_FENCE();
#define PV_REST(vp_) \
        VLOAD(vB, vp_, 1); SCHED_FENCE(); \
        _Pragma("unroll") for (int s4 = 0; s4 < 4; ++s4) o[0] = MFMA32(__builtin_bit_cast(bf16x8, pa[s4]), __builtin_bit_cast(bf16x8, vA[s4]), o[0]); \
        SCHED_FENCE(); VLOAD(vA, vp_, 2); SCHED_FENCE(); \
        _Pragma("unroll") for (int s4 = 0; s4 < 4; ++s4) o[1] = MFMA32(__builtin_bit_cast(bf16x8, pa[s4]), __builtin_bit_cast(bf16x8, vB[s4]), o[1]); \
        SCHED_FENCE(); VLOAD(vB, vp_, 3); SCHED_FENCE(); \
        _Pragma("unroll") for (int s4 = 0; s4 < 4; ++s4) o[2] = MFMA32(__builtin_bit_cast(bf16x8, pa[s4]), __builtin_bit_cast(bf16x8, vA[s4]), o[2]); \
        SCHED_FENCE(); \
        _Pragma("unroll") for (int s4 = 0; s4 < 4; ++s4) o[3] = MFMA32(__builtin_bit_cast(bf16x8, pa[s4]), __builtin_bit_cast(bf16x8, vB[s4]), o[3]); \
        SCHED_FENCE();
#define VCHUNK(dst, c_) do { _Pragma("unroll") for (int nt_ = 0; nt_ < 4; ++nt_) dst[nt_] = *(const LAS u32x4*)(vp + nt_ * 32 * PV + (c_) * 32); } while (0)
#define SMCHUNK(dst, P, B) do { _Pragma("unroll") for (int r_ = 0; r_ < 8; ++r_) { P[(B) + r_] = __builtin_amdgcn_exp2f(P[(B) + r_]); lsum += P[(B) + r_]; } \
            dst = (u32x4){pk2(P[(B)], P[(B) + 1]), pk2(P[(B) + 2], P[(B) + 3]), pk2(P[(B) + 4], P[(B) + 5]), pk2(P[(B) + 6], P[(B) + 7])}; } while (0)
#define PVCHUNK(pa_, v_) do { _Pragma("unroll") for (int nt_ = 0; nt_ < 4; ++nt_) o[nt_] = MFMA32(__builtin_bit_cast(bf16x8, pa_), __builtin_bit_cast(bf16x8, v_[nt_]), o[nt_]); } while (0)
#define INTERLEAVE() do { __builtin_amdgcn_sched_group_barrier(0x100, 4, 0); \
            __builtin_amdgcn_sched_group_barrier(0x008, 1, 0); __builtin_amdgcn_sched_group_barrier(0x002, 6, 0); __builtin_amdgcn_sched_group_barrier(0x008, 1, 0); __builtin_amdgcn_sched_group_barrier(0x002, 6, 0); \
            __builtin_amdgcn_sched_group_barrier(0x008, 1, 0); __builtin_amdgcn_sched_group_barrier(0x002, 6, 0); __builtin_amdgcn_sched_group_barrier(0x008, 1, 0); __builtin_amdgcn_sched_group_barrier(0x002, 6, 0); } while (0)
#define WRITEH(so_, j_, RK, RV) do { _Pragma("unroll") for (int i = 0; i < 2; ++i) { const int q = tid + 512 * i; \
                *(LAS u32x4*)(lds + (so_) + ((j_) * 64 + (q >> 4)) * PK + (q & 15) * 16) = RK[i]; \
                LAS unsigned char* vd = lds + (so_) + KST + (q >> 3) * PV + (j_) * 128 + ((q & 7) >> 1) * 32 + (q & 1) * 8;     \
                *(LAS u32x2*)vd = (u32x2){RV[i].x, RV[i].y}; *(LAS u32x2*)(vd + 16) = (u32x2){RV[i].z, RV[i].w}; } } while (0)
#define SUBTILE(kt_, so_, j_) { \
            const LAS unsigned char* vp = lds + (so_) + KST + r32 * PV + (j_) * 128 + hi * 16; \
            bf16x8 kf1[4]; \
            ST_MFMA(kt_, (so_) + (j_) * 64 * PK) \
            u32x4 vA[4], vB[4]; u32x4 paA, paB; \
            if (!(farp || farn)) { const int ib = kv0 + 4 * hi - (q0 + r32) + 2047; \
                _Pragma("unroll") for (int r = 0; r < 16; ++r) { const int idx = ib + (r & 3) + 8 * (r >> 2); p0[r] += bt[idx]; } SCHED_FENCE(); } \
              \
            SMCHUNK(paA, p0, 0); \
            _Pragma("unroll") for (int ks = 0; ks < 4; ++ks) p1 = MFMA32(kf1[ks], qv[ks], p1); \
            __builtin_amdgcn_sched_group_barrier(0x008, 1, 0); __builtin_amdgcn_sched_group_barrier(0x002, 6, 0); __builtin_amdgcn_sched_group_barrier(0x008, 1, 0); __builtin_amdgcn_sched_group_barrier(0x002, 6, 0); \
            __builtin_amdgcn_sched_group_barrier(0x008, 1, 0); __builtin_amdgcn_sched_group_barrier(0x002, 6, 0); __builtin_amdgcn_sched_group_barrier(0x008, 1, 0); __builtin_amdgcn_sched_group_barrier(0x002, 6, 0); \
            SCHED_FENCE(); \
            VCHUNK(vA, 0); SCHED_FENCE(); \
            if (!(farp || farn)) { const int ib = kv0 + 4 * hi - (q0 + r32) + 2047; \
                _Pragma("unroll") for (int r = 0; r < 16; ++r) { const int idx = ib + (r & 3) + 8 * (r >> 2); p1[r] += bt[idx + 32]; } SCHED_FENCE(); } \
            VCHUNK(vB, 1); SMCHUNK(paB, p0, 8); PVCHUNK(paA, vA); INTERLEAVE(); SCHED_FENCE(); \
            VCHUNK(vA, 2); SMCHUNK(paA, p1, 0); PVCHUNK(paB, vB); INTERLEAVE(); SCHED_FENCE(); \
            VCHUNK(vB, 3); SMCHUNK(paB, p1, 8); PVCHUNK(paA, vA); INTERLEAVE(); SCHED_FENCE(); \
            PVCHUNK(paB, vB); SCHED_FENCE(); }
        WRITEH(0, 0, rkA, rvA); AT_LOAD(1, rkA, rvA); WRITEH(0, 1, rkA, rvA);
        if (w >= 4) __builtin_amdgcn_s_setprio(1);
        for (int T = 0; T < 16; ++T) { const int so = (T & 1) * STG, sn = STG - so;
            BAR_LDS();
            if (T + 1 < 16) AT_LOAD(2 * T + 2, rkA, rvA); else if (has_next) AT_LOADB(kbase_n, vbase_n, 0, rkA, rvA);
            SUBTILE(2 * T, so, 0)
            if (T + 1 < 16) { WRITEH(sn, 0, rkA, rvA); AT_LOAD(2 * T + 3, rkA, rvA); }
            SUBTILE(2 * T + 1, so, 1)
            if (T + 1 < 16) WRITEH(sn, 1, rkA, rvA);
        }
        __builtin_amdgcn_s_setprio(0);
        if (has_next) Q_LOAD(bn, hn, q0n);
#undef VCHUNK
#undef SMCHUNK
#undef PVCHUNK
#undef INTERLEAVE
#undef SUBTILE
#undef WRITEH
#undef AT_LOAD
#undef VLOAD
#undef ST_MFMA
#undef ST_SOFTMAX
#undef PV_REST
        lsum += __shfl_xor(lsum, 32);
        if (hi == 0) ls[w * 32 + r32] = lsum;
        BAR_LDS();
        float rl[16];
#pragma unroll
        for (int r = 0; r < 16; ++r) rl[r] = __builtin_amdgcn_rcpf(ls[w * 32 + crow(r, hi)]);
        LAS float* o2 = (LAS float*)lds;
        if (st == 1) {
#pragma unroll
            for (int nt = 0; nt < 4; ++nt)
#pragma unroll
                for (int r = 0; r < 16; ++r) o2[(wq * 32 + crow(r, hi)) * 128 + nt * 32 + r32] = o[nt][r] * rl[r] * lam; }
        BAR_LDS();
        if (st == 0) {
#pragma unroll
            for (int r = 0; r < 16; ++r) { const int ql = wq * 32 + crow(r, hi);
#pragma unroll
                for (int nt = 0; nt < 4; ++nt) o[nt][r] = o[nt][r] * rl[r] - o2[ql * 128 + nt * 32 + r32]; } }
        BAR_LDS();
        if (st == 0) { float gsub[4];
#pragma unroll
            for (int nt = 0; nt < 4; ++nt) gsub[nt] = subg[nt * 32 + r32] * oml;
#pragma unroll
            for (int r = 0; r < 16; ++r) { const int ql = wq * 32 + crow(r, hi); float ss = 0.f;
#pragma unroll
                for (int nt = 0; nt < 4; ++nt) ss += o[nt][r] * o[nt][r];
                ss += __shfl_xor(ss, 1); ss += __shfl_xor(ss, 2); ss += __shfl_xor(ss, 4); ss += __shfl_xor(ss, 8); ss += __shfl_xor(ss, 16);
                const float rs = rsqrtf(ss * (1.f / 128.f) + EPS);
                LAS bf16_t* srow = (LAS bf16_t*)lds + ql * 136 + r32;
#pragma unroll
                for (int nt = 0; nt < 4; ++nt) srow[nt * 32] = f2bf(o[nt][r] * rs * gsub[nt]); } }
        BAR_LDS();
        { bf16_t* obase = AO + (size_t)(b * 2048 + qb * 128) * DM + h * 128;
#pragma unroll
          for (int i = 0; i < 4; ++i) { const int pc = tid + 512 * i, row = pc >> 4, ch = pc & 15;
              const LAS u32x2* sp = (const LAS u32x2*)((LAS bf16_t*)lds + row * 136 + ch * 8); const u32x2 a0 = sp[0], a1 = sp[1];
              *(u32x4*)(obase + (size_t)row * DM + ch * 8) = (u32x4){a0.x, a0.y, a1.x, a1.y}; } }
    }
}

struct Params { const float* in[15]; float* out; unsigned char* ws; };

__global__ void __launch_bounds__(512) mega_fwd(Params p) {
    extern __shared__ __attribute__((aligned(16))) unsigned char lds_raw[];
    LAS unsigned char* lds = (LAS unsigned char*)lds_raw;
    cg::grid_group grid = cg::this_grid();
#define GRID_SYNC() do { asm volatile("s_waitcnt vmcnt(0)" ::: "memory"); grid.sync(); __builtin_amdgcn_fence(__ATOMIC_ACQUIRE, "agent"); asm volatile("s_waitcnt vmcnt(0)" ::: "memory"); } while (0)
    const int wave_s = __builtin_amdgcn_readfirstlane(threadIdx.x >> 6);
    const int G = gridDim.x, bx = blockIdx.x; const int vcu = (G % 8 == 0) ? (bx % 8) * (G / 8) + bx / 8 : bx;
#define WS_PTRS() size_t wz_ = 0; asm volatile("" : "+s"(wz_)); unsigned char* ws = p.ws + wz_;     \
    unsigned char* big = ws + OFF_BIG; const float* SMALLP = (const float*)(ws + OFF_SMALL); (void)big; (void)SMALLP

#ifdef POISON_WORD
    {
        WS_PTRS();
        u32x4* pz = (u32x4*)(ws + OFF_XB); const size_t n16 = (WS_END - OFF_XB) / 16;
        for (size_t i = (size_t)bx * 512 + TIDX(); i < n16; i += (size_t)G * 512) pz[i] = (u32x4){POISON_WORD, POISON_WORD, POISON_WORD, POISON_WORD};
    }
    GRID_SYNC();
#endif
    volatile LAS unsigned* bst = (volatile LAS unsigned*)(lds + LDS_BYTES - 64);
    if (TIDX() < 2) bst[TIDX()] = 0u;
    __syncthreads();
    XcdBarrier xbar = xcd_barrier_post((unsigned*)(p.ws + OFF_CTL), bst, wave_s);
#define XCD_SYNC() do { XcdBarrier xb2_ = xbar; size_t bz_ = 0; asm volatile("" : "+s"(bz_), "+s"(xb2_.x)); xb2_.bar = (unsigned*)(p.ws + OFF_CTL + bz_); xcd_barrier(xb2_, wave_s); } while (0)
    {
        WS_PTRS();
        int tid_ = TIDX(); asm volatile("" : "+v"(tid_)); const int tid = tid_, lane = tid & 63, wave = __builtin_amdgcn_readfirstlane(tid >> 6);
        const int gw = vcu * 8 + wave, NGW = G * 8;
        const float* x_in = p.in[0]; const float* norm_g = p.in[1]; const float* w_gu = p.in[2]; const float* w_dn = p.in[3];
        const float* gla_w_in = p.in[4]; const float* gla_w_out = p.in[8]; const float* diff_w_in = p.in[9]; const float* diff_qkg = p.in[10]; const float* diff_w_out = p.in[13]; const float* rel_tab = p.in[14];
        bf16_t* WGU = (bf16_t*)(ws + OFF_WGU); bf16_t* WDN = (bf16_t*)(ws + OFF_WDN); bf16_t* WGA = (bf16_t*)(ws + OFF_WGA); bf16_t* WGV = (bf16_t*)(ws + OFF_WGV); bf16_t* WGO = (bf16_t*)(ws + OFF_WGO);
        bf16_t* WDQK = (bf16_t*)(ws + OFF_WDQK); bf16_t* WDV = (bf16_t*)(ws + OFF_WDV); bf16_t* WDO = (bf16_t*)(ws + OFF_WDO);
        bf16_t* XB = (bf16_t*)(ws + OFF_XB); u64* SSQ = (u64*)(ws + OFF_SSQ); float* BIASM = (float*)(ws + OFF_BIASM); float* SMALLW = (float*)(ws + OFF_SMALL);
        LAS float* scr = (LAS float*)(lds + wave * 16384);
#ifndef REP_P0
#define REP_P0 1
#endif
        for (int rep_ = 0; rep_ < REP_P0; ++rep_) {
        for (int gi = gw; gi < 42240; gi += NGW) {
            const float* W; int ldw, K, nblk, type = 0, coff = 0, r; bf16_t* dst; const float* gv = nullptr;
            if (gi < 33792) { const int lf = gi / 4224, l = lf >> 1, f = lf & 1; r = gi % 4224;
                if (r < 2816) { W = w_gu + (size_t)lf * DM * 2 * DFF; ldw = 2 * DFF; K = DM; nblk = 176; dst = WGU + (size_t)lf * 2 * DFF * DM; gv = norm_g + (l * 3 + (f ? 2 : 0)) * DM; type = 1; }
                else { r -= 2816; W = w_dn + (size_t)lf * DFF * DM; ldw = DM; K = DFF; nblk = 32; dst = WDN + (size_t)lf * DM * DFF; }
            } else { const int g2 = gi - 33792, j = g2 / 4224; r = g2 % 4224;
                if (r < 1152) { W = gla_w_in + (size_t)j * DM * 3104; ldw = 3104; K = DM; nblk = 72; dst = WGA + (size_t)j * 2304 * DM; gv = norm_g + ((2 * j) * 3 + 1) * DM; type = 2; }
                else if (r < 1664) { r -= 1152; W = gla_w_in + (size_t)j * DM * 3104; ldw = 3104; K = DM; nblk = 32; dst = WGV + (size_t)j * DM * DM; gv = norm_g + ((2 * j) * 3 + 1) * DM; coff = 1024; }
                else if (r < 2176) { r -= 1664; W = gla_w_out + (size_t)j * DM * DM; ldw = DM; K = DM; nblk = 32; dst = WGO + (size_t)j * DM * DM; }
                else if (r < 3200) { r -= 2176; W = diff_w_in + (size_t)j * DM * 3072; ldw = 3072; K = DM; nblk = 64; dst = WDQK + (size_t)j * 2048 * DM; gv = norm_g + ((2 * j + 1) * 3 + 1) * DM; type = 3; }
                else if (r < 3712) { r -= 3200; W = diff_w_in + (size_t)j * DM * 3072; ldw = 3072; K = DM; nblk = 32; dst = WDV + (size_t)j * DM * DM; gv = norm_g + ((2 * j + 1) * 3 + 1) * DM; coff = 2048; }
                else { r -= 3712; W = diff_w_out + (size_t)j * DM * DM; ldw = DM; K = DM; nblk = 32; dst = WDO + (size_t)j * DM * DM; } }
            const int kb = r / nblk, nb = r % nblk; int src = coff + 32 * nb; float scale = 1.f;
            if (type == 1) { const int pn = nb >> 3, rho = (nb & 7) * 32; src = (rho >> 7) * DFF + 128 * pn + (rho & 127); }
            else if (type == 2) { if (nb < 16) { src = 32 * nb; scale = 0.08838834764831845f; } else if (nb < 32) src = 32 * nb; else if (nb < 64) src = 2048 + 32 * (nb - 32); else if (nb == 64) src = 3072; else src = -1; }
            else if (type == 3) { const int pn = nb >> 3, rho = (nb & 7) * 32, bj = rho >> 7, wc = (rho & 127) >> 5; src = 256 * pn + 64 * wc + 32 * bj; }
            transpose_item(W, ldw, src, kb * 64, gv, scale, dst + (size_t)nb * 32 * K, K, scr, lane);
        }
        }
        for (int m = gw; m < M_TOK; m += NGW) { const f32x4* xr = (const f32x4*)(x_in + (size_t)m * DM) + lane; u32x2* xbo = (u32x2*)(XB + (size_t)m * DM) + lane;
            float s = 0.f;
#pragma unroll
            for (int jj = 0; jj < 4; ++jj) { const f32x4 v = xr[64 * jj]; u32x2 wv; wv.x = pk2(v[0], v[1]); wv.y = pk2(v[2], v[3]); xbo[64 * jj] = wv; s += (v[0] * v[0] + v[1] * v[1]) + (v[2] * v[2] + v[3] * v[3]); }
            s = wave_sum(s);
            if (lane == 0) { SSQ[m] = (u64)(s * SSQ_SCALE); SSQ[M_TOK + m] = 0ull; } }
        for (int idx = bx * 512 + tid; idx < SM_TOTAL; idx += G * 512) { float v;
            if (idx < SM_BG) v = p.in[5][idx]; else if (idx < SM_GON) v = p.in[6][idx - SM_BG]; else if (idx < SM_QKG) v = p.in[7][idx - SM_GON];
            else if (idx < SM_LAM) v = p.in[10][idx - SM_QKG]; else if (idx < SM_SUBG) v = p.in[11][idx - SM_LAM]; else v = p.in[12][idx - SM_SUBG];
            SMALLW[idx] = v; }
        for (int idx = bx * 512 + tid; idx < 2 * 8 * 4096; idx += G * 512) { const int j = idx >> 15, h = (idx >> 12) & 7, ri = idx & 4095;
            float mq = 0.f, mk = 0.f, mb = 0.f;
            for (int d = 0; d < 64; ++d) { mq = fmaxf(mq, fabsf(diff_qkg[(j * 2 + 0) * 64 + d])); mk = fmaxf(mk, fabsf(diff_qkg[(j * 2 + 1) * 64 + d])); }
            for (int bk = 0; bk < 32; ++bk) mb = fmaxf(mb, fabsf(rel_tab[bk * 8 + h]));
            const float smax = 8.f * mq * mk + mb; const int rel = ri - 2047;
            BIASM[idx] = (ri < 4095) ? (rel_tab[t5_bucket(rel) * 8 + h] - smax) * LOG2E : 0.f; }
    }
    if (p.ws == nullptr) GRID_SYNC();
    XCD_SYNC();

    #ifndef REP_INPROJ
#define REP_INPROJ 1
#endif
    int resk = 0;
    for (int layer_i = 0; layer_i < 4; ++layer_i) {
        for (int step = 0; step < 10; ++step) {
#ifdef MAXSTEP
            if (layer_i * 10 + step >= MAXSTEP) break;
#endif
            int layer = layer_i; asm volatile("" : "+s"(layer));
            const int j = layer >> 1; const bool is_gla = (layer & 1) == 0;
            bool sync_after = true;
            if (step == 0 || step == 8) { WS_PTRS(); const int lf = layer * 2 + (step == 8 ? 1 : 0);
                Gemm g{(const bf16_t*)(ws + OFF_XB), (const bf16_t*)(ws + OFF_WGU) + (size_t)lf * 2 * DFF * DM, M_TOK, 2 * DFF, DM}; pg8::StaticOrder S; S.init(M_TOK, 2 * DFF, G, bx);
                stage_rstd(S, (const u64*)(ws + OFF_SSQ) + (size_t)(resk & 1) * M_TOK, lds, 0, wave_s);
                EpiGU E{(bf16_t*)(big + BIG_ACT), lds, 0};

#ifndef NO_GU
#ifndef REP_GU
#define REP_GU 1
#endif
for (int rep_ = 0; rep_ < REP_GU; ++rep_) pg8::gemm_phase<EpiGU, pg8::StaticOrder, true, true>(lds, g, S, E, wave_s);
#endif

            } else if (step == 1 || step == 7 || step == 9) { WS_PTRS();
                Gemm g; float alpha;
                if (step == 7) { g = Gemm{(const bf16_t*)(big + BIG_QE), (const bf16_t*)(ws + (is_gla ? OFF_WGO : OFF_WDO)) + (size_t)j * DM * DM, M_TOK, DM, DM}; alpha = 1.f; }
                else { const int lf = layer * 2 + (step == 9 ? 1 : 0); g = Gemm{(const bf16_t*)(big + BIG_ACT), (const bf16_t*)(ws + OFF_WDN) + (size_t)lf * DM * DFF, M_TOK, DM, DFF}; alpha = 0.5f; }
                pg8::StaticOrder S; S.init(M_TOK, DM, G, bx);
                float* xres = nullptr; if (layer == 3 && step == 9) { size_t oz_ = 0; asm volatile("" : "+s"(oz_)); xres = p.out + oz_; }
                EpiRes E{xres, (bf16_t*)(ws + OFF_XB), (u64*)(ws + OFF_SSQ) + (size_t)((resk + 1) & 1) * M_TOK, (u64*)(ws + OFF_SSQ) + (size_t)(resk & 1) * M_TOK, alpha, 0};

#ifndef NO_RES
#ifdef REP_DN
 if (step != 7) { EpiRes E2 = E; E2.alpha = 0.f; E2.dry = 1; pg8::gemm_phase<EpiRes, pg8::StaticOrder, true, true>(lds, g, S, E2, wave_s); }
#endif
pg8::gemm_phase<EpiRes, pg8::StaticOrder, true, true>(lds, g, S, E, wave_s);
#endif

                ++resk;
            } else if (step == 2) { WS_PTRS(); sync_after = is_gla; const u64* ssq = (const u64*)(ws + OFF_SSQ) + (size_t)(resk & 1) * M_TOK;
                if (is_gla) { Gemm g{(const bf16_t*)(ws + OFF_XB), (const bf16_t*)(ws + OFF_WGA) + (size_t)j * 2304 * DM, M_TOK, 2304, DM}; pg8::StaticOrder S; S.init(M_TOK, 2304, G, bx);
                    stage_rstd(S, ssq, lds, 0, wave_s);
                    EpiGlaA E{(bf16_t*)(big + BIG_QK), (bf16_t*)(big + BIG_G), (float*)(big + BIG_LR), lds, 0};

#ifndef NO_GLAA
for (int rep_ = 0; rep_ < REP_INPROJ; ++rep_) pg8::gemm_phase<EpiGlaA, pg8::StaticOrder, true, true>(lds, g, S, E, wave_s);
#endif

                } else { Gemm g{(const bf16_t*)(ws + OFF_XB), (const bf16_t*)(ws + OFF_WDQK) + (size_t)j * 2048 * DM, M_TOK, 2048, DM}; pg8::StaticOrder S; S.init(M_TOK, 2048, G, bx);
                    stage_rstd(S, ssq, lds, 0, wave_s);
                    EpiQkDiff E{(bf16_t*)(big + BIG_QK), lds, SMALLP + SM_QKG + (j * 2 + 0) * 64, SMALLP + SM_QKG + (j * 2 + 1) * 64, 0};

#ifndef NO_QKD
for (int rep_ = 0; rep_ < REP_INPROJ; ++rep_) pg8::gemm_phase<EpiQkDiff, pg8::StaticOrder, true, true>(lds, g, S, E, wave_s);
#endif
 }
            } else if (step == 3) { WS_PTRS(); sync_after = !is_gla; const u64* ssq = (const u64*)(ws + OFF_SSQ) + (size_t)(resk & 1) * M_TOK;
                if (is_gla) { Gemm g{(const bf16_t*)(ws + OFF_WGV) + (size_t)j * DM * DM, (const bf16_t*)(ws + OFF_XB), DM, M_TOK, DM}; pg8::StaticOrder S; S.init(DM, M_TOK, G, bx);
                    stage_rstd(S, ssq, lds, 1, wave_s);
                    EpiVt<0> E{(bf16_t*)(big + BIG_VT), lds, 0};

#ifndef NO_VT0
for (int rep_ = 0; rep_ < REP_INPROJ; ++rep_) pg8::gemm_phase<EpiVt<0>, pg8::StaticOrder, true, true>(lds, g, S, E, wave_s);
#endif

                } else { Gemm g{(const bf16_t*)(ws + OFF_WDV) + (size_t)j * DM * DM, (const bf16_t*)(ws + OFF_XB), DM, M_TOK, DM}; pg8::StaticOrder S; S.init(DM, M_TOK, G, bx);
                    stage_rstd(S, ssq, lds, 1, wave_s);
                    EpiVt<1> E{(bf16_t*)(big + BIG_VT), lds, 0};

#ifndef NO_VT1
for (int rep_ = 0; rep_ < REP_INPROJ; ++rep_) pg8::gemm_phase<EpiVt<1>, pg8::StaticOrder, true, true>(lds, g, S, E, wave_s);
#endif
 }
            } else if (step == 4) { WS_PTRS();

#ifndef NO_PREP
#ifndef REP_PREP
#define REP_PREP 1
#endif
if (is_gla) for (int rep_ = 0; rep_ < REP_PREP; ++rep_) gla_prep(lds, (const bf16_t*)(big + BIG_QK), (const float*)(big + BIG_LR), SMALLP + SM_W2 + (size_t)j * 2 * 16 * 512, SMALLP + SM_BG + j * 2 * 512,
                                     (bf16_t*)(big + BIG_QE), (bf16_t*)(big + BIG_KE), (bf16_t*)(big + BIG_KDT), (float*)(big + BIG_EBE), vcu, G, wave_s);
#else
if(0){}
#endif
                else { const float* lv = SMALLP + SM_LAM + j * 256; float s01 = 0.f, s23 = 0.f;
                    for (int d = 0; d < 64; ++d) { s01 += lv[d] * lv[64 + d]; s23 += lv[128 + d] * lv[192 + d]; }
                    const float lam_init = (layer == 1) ? 0.35550906759096926f : 0.5560582041556405f;     const float lam = __expf(s01) - __expf(s23) + lam_init;

#ifndef NO_ATTN
#ifndef REP_ATTN
#define REP_ATTN 1
#endif
 for (int rep_ = 0; rep_ < REP_ATTN; ++rep_) attn_phase(lds, (const bf16_t*)(big + BIG_QK), (const bf16_t*)(big + BIG_VT), (bf16_t*)(big + BIG_QE), (const float*)(ws + OFF_BIASM) + (size_t)j * 8 * 4096, lam, SMALLP + SM_SUBG + j * 128, 1.f - lam_init, vcu, G, wave_s);
#endif
 }
            } else if (step == 5) {

#ifndef NO_SCAN
#ifndef REP_SCAN
#define REP_SCAN 1
#endif
if (is_gla) { WS_PTRS(); for (int rep_ = 0; rep_ < REP_SCAN; ++rep_) gla_scan(lds, (const bf16_t*)(big + BIG_QE), (const bf16_t*)(big + BIG_KE), (const bf16_t*)(big + BIG_KDT), (const float*)(big + BIG_EBE), (const bf16_t*)(big + BIG_VT),
                                                  (bf16_t*)(big + BIG_QK), (bf16_t*)(big + BIG_OBB), vcu, G, wave_s); } else
#endif
 sync_after = false;
            } else if (step == 6) {

#ifndef NO_COMB
#ifndef REP_COMB
#define REP_COMB 1
#endif
if (is_gla) { WS_PTRS(); for (int rep_ = 0; rep_ < REP_COMB; ++rep_) gla_combine((const bf16_t*)(big + BIG_QK), (const bf16_t*)(big + BIG_OBB), (const bf16_t*)(big + BIG_G), SMALLP + SM_GON + j * 256, (bf16_t*)(big + BIG_QE), vcu, G, wave_s); } else
#endif
 sync_after = false;
            }
            if (sync_after && !(layer == 3 && step == 9)) XCD_SYNC();
        }
    }
}

extern "C" void kernel_launch(void* const* d_in, const int* in_sizes, int n_in, void* d_out, int out_size, void* d_ws, size_t ws_size, hipStream_t stream) {
    static int grid_blocks = 0;
    if (grid_blocks == 0) {
        if (n_in != 15 || out_size != M_TOK * DM || ws_size < WS_END) { fprintf(stderr, "kernel_launch: unexpected shapes (n_in %d out %d ws %zu need %zu)\n", n_in, out_size, ws_size, (size_t)WS_END); grid_blocks = -1; return; }
        int dev = 0, cus = 0, per_cu = 0;
        hipGetDevice(&dev); hipDeviceGetAttribute(&cus, hipDeviceAttributeMultiprocessorCount, dev);
        if (hipFuncSetAttribute((const void*)mega_fwd, hipFuncAttributeMaxDynamicSharedMemorySize, LDS_BYTES) != hipSuccess) { fprintf(stderr, "kernel_launch: hipFuncSetAttribute failed\n"); grid_blocks = -1; return; }
        if (hipOccupancyMaxActiveBlocksPerMultiprocessor(&per_cu, (const void*)mega_fwd, 512, LDS_BYTES) != hipSuccess || per_cu < 1) { fprintf(stderr, "kernel_launch: occupancy query gave %d\n", per_cu); per_cu = 1; }
        (void)hipGetLastError();
        grid_blocks = cus * 1;
        if (grid_blocks < 188) { fprintf(stderr, "kernel_launch: %d CUs: the per-unit rstd tables in LDS hold at most 15 GEMM units per workgroup (needs >= 188 workgroups); nothing launched\n", grid_blocks); grid_blocks = -1; return; }
    }
    if (grid_blocks < 0) return;
    if (hipMemsetAsync((char*)d_ws + OFF_CTL, 0, 16384, stream) != hipSuccess) { fprintf(stderr, "kernel_launch: memset of the barrier words failed\n"); return; }
    Params p{};
    for (int i = 0; i < 15; ++i) p.in[i] = (const float*)d_in[i];
    p.out = (float*)d_out; p.ws = (unsigned char*)d_ws;
    void* args[] = {&p};
    hipError_t e = hipLaunchCooperativeKernel((const void*)mega_fwd, dim3(grid_blocks), dim3(512), args, LDS_BYTES, stream);
    if (e != hipSuccess) fprintf(stderr, "cooperative launch failed: %s (grid %d)\n", hipGetErrorString(e), grid_blocks);
}
```
